# Optimizing an MI355X kernel written in HIP

```python
import jax, jax.numpy as jnp
from jax import lax
import numpy as np

D_MODEL = 1024
BATCH = 8
SEQ = 4096
DEPTH = 2

DIL_GROUPS = ((128, 1), (512, 4), (2048, 16))
N_GROUPS = 3
A_HEADS = 8
A_HEAD_DIM = 64
A_WIDTH = N_GROUPS * A_HEADS * A_HEAD_DIM
A_OUT = A_HEADS * A_HEAD_DIM
ROT_DIM = A_HEAD_DIM // 4
ROPE_THETA = 500000.0
ATT_BLOCK = 128
NEG_INF = -1e30
R_HEADS = 4
R_KEY_DIM = 128
R_VAL_DIM = 256
R_QK = R_HEADS * R_KEY_DIM
R_V = R_HEADS * R_VAL_DIM
R_CHUNK = 128
R_ROT_BASE = 10000.0
D_FF = 4 * D_MODEL
NORM_EPS = 1e-6

_SIZES = (A_WIDTH, A_WIDTH, A_WIDTH, R_QK, R_QK, R_V, R_V, D_MODEL, D_MODEL)
D_IN = sum(_SIZES)
SPLIT_POINTS = tuple(sum(_SIZES[:i + 1]) for i in range(len(_SIZES) - 1))

kernel_name = "dilated_attn_retention_gated_hybrid"


def rmsnorm(x, g):
    xf = x.astype(jnp.float32)
    y = xf * lax.rsqrt(jnp.mean(xf * xf, axis=-1, keepdims=True) + NORM_EPS)
    return (y * g.astype(jnp.float32)).astype(x.dtype)


def rotary(x, pos, rot_dim, base):
    half = rot_dim // 2
    inv = 1.0 / (base ** (jnp.arange(half, dtype=jnp.float32) / half))
    ang = pos.astype(jnp.float32)[:, None] * inv[None, :]
    cos = jnp.cos(ang)[None, :, None, :]
    sin = jnp.sin(ang)[None, :, None, :]
    xr = x[..., :rot_dim].astype(jnp.float32)
    x1, x2 = xr[..., :half], xr[..., half:]
    rot = jnp.concatenate([x1 * cos - x2 * sin, x1 * sin + x2 * cos], axis=-1).astype(x.dtype)
    return jnp.concatenate([rot, x[..., rot_dim:]], axis=-1)


def dilated_group_attention(q, k, v, window, dilation):
    b, s, h, dh = q.shape
    span = dilation * ATT_BLOCK
    L = -(-s // span) * span
    n_sub = L // dilation
    nb = n_sub // ATT_BLOCK
    reach = window // dilation

    def to_blocks(t):
        t = jnp.pad(t, ((0, 0), (0, L - s), (0, 0), (0, 0)))
        t = t.reshape(b, n_sub, dilation, h, dh).transpose(0, 2, 3, 1, 4)
        return t.reshape(b, dilation, h, nb, ATT_BLOCK, dh)

    def with_prev(t):
        prev = jnp.pad(t, ((0, 0), (0, 0), (0, 0), (1, 0), (0, 0), (0, 0)))[:, :, :, :-1]
        return jnp.concatenate([prev, t], axis=-2)

    qb, kb, vb = to_blocks(q), to_blocks(k), to_blocks(v)
    kk, vv = with_prev(kb), with_prev(vb)
    scores = jnp.einsum('brhnqd,brhnkd->brhnqk', qb, kk).astype(jnp.float32) * (dh ** -0.5)
    qi = jnp.arange(ATT_BLOCK)[:, None]
    kj = jnp.arange(2 * ATT_BLOCK)[None, :]
    dist = qi + ATT_BLOCK - kj
    band = (dist >= 0) & (dist <= reach)
    blk = jnp.arange(nb)[:, None, None]
    mask = band[None] & ((blk > 0) | (kj >= ATT_BLOCK)[None])
    scores = jnp.where(mask, scores, NEG_INF)
    m = jnp.max(scores, axis=-1, keepdims=True)
    p = jnp.exp(scores - m)
    den = jnp.sum(p, axis=-1, keepdims=True)
    out = jnp.einsum('brhnqk,brhnkd->brhnqd', (p / den).astype(v.dtype), vv)
    lse = (m + jnp.log(den))[..., 0]

    def from_blocks(t):
        rest = t.shape[5:]
        t = t.reshape((b, dilation, h, n_sub) + rest)
        t = jnp.moveaxis(t, 3, 1)
        return t.reshape((b, L, h) + rest)[:, :s]

    return from_blocks(out), from_blocks(lse)


def retention(q, k, v):
    b, s, h, dk = q.shape
    dv = v.shape[-1]
    nc = s // R_CHUNK
    C = R_CHUNK
    lg = jnp.log1p(-(2.0 ** (-5.0 - jnp.arange(h, dtype=jnp.float32))))

    def chunks(t, d):
        return t.astype(jnp.float32).reshape(b, nc, C, h, d).transpose(0, 3, 1, 2, 4)

    qc = chunks(q, dk)
    kc = chunks(k, dk) * (dk ** -0.5)
    vc = chunks(v, dv)
    idx = jnp.arange(C, dtype=jnp.float32)
    diff = idx[:, None] - idx[None, :]
    decay = jnp.where(diff >= 0, jnp.exp(diff[None] * lg[:, None, None]), 0.0)
    zeta = jnp.exp((C - 1 - idx)[None, :] * lg[:, None])
    xi = jnp.exp((idx + 1)[None, :] * lg[:, None])
    chunk_decay = jnp.exp(C * lg)[None, :, None, None]

    inner_s = jnp.einsum('bhncd,bhnmd->bhncm', qc, kc) * decay[None, :, None]
    inner = jnp.einsum('bhncm,bhnme->bhnce', inner_s, vc)
    kv = jnp.einsum('bhncd,bhnce->bhnde', kc * zeta[None, :, None, :, None], vc)

    def step(state, kv_i):
        return state * chunk_decay + kv_i, state

    _, prev_states = lax.scan(step, jnp.zeros((b, h, dk, dv), jnp.float32), jnp.moveaxis(kv, 2, 0))
    prev_states = jnp.moveaxis(prev_states, 0, 2)
    cross = jnp.einsum('bhncd,bhnde->bhnce', qc * xi[None, :, None, :, None], prev_states)
    out = inner + cross
    return out.transpose(0, 2, 3, 1, 4).reshape(b, s, h, dv)


def hybrid_layer(x, g_mix, w_in, w_a, w_b, w_o, g_ffn, w_up, w_down):
    b, s, _ = x.shape
    pos = jnp.arange(s)
    hn = rmsnorm(x, g_mix)
    proj = hn @ w_in
    qa, ka, va, qr, kr, vr, gr, ga, gb = jnp.split(proj, SPLIT_POINTS, axis=-1)

    def heads_a(t):
        return t.reshape(b, s, N_GROUPS * A_HEADS, A_HEAD_DIM)
    qa = rotary(heads_a(qa), pos, ROT_DIM, ROPE_THETA).reshape(b, s, N_GROUPS, A_HEADS, A_HEAD_DIM)
    ka = rotary(heads_a(ka), pos, ROT_DIM, ROPE_THETA).reshape(b, s, N_GROUPS, A_HEADS, A_HEAD_DIM)
    va = va.reshape(b, s, N_GROUPS, A_HEADS, A_HEAD_DIM)
    outs, lses = [], []
    for gi, (window, dilation) in enumerate(DIL_GROUPS):
        o, l = dilated_group_attention(qa[:, :, gi], ka[:, :, gi], va[:, :, gi], window, dilation)
        outs.append(o.astype(jnp.float32))
        lses.append(l)
    wts = jax.nn.softmax(jnp.stack(lses, axis=0), axis=0)
    y_a = jnp.sum(wts[..., None] * jnp.stack(outs, axis=0), axis=0).astype(x.dtype)
    y_a = y_a.reshape(b, s, A_OUT) @ w_a

    qr = rotary(qr.reshape(b, s, R_HEADS, R_KEY_DIM), pos, R_KEY_DIM, R_ROT_BASE)
    kr = rotary(kr.reshape(b, s, R_HEADS, R_KEY_DIM), pos, R_KEY_DIM, R_ROT_BASE)
    ret = retention(qr, kr, vr.reshape(b, s, R_HEADS, R_VAL_DIM))
    ret = ret * lax.rsqrt(jnp.mean(ret * ret, axis=-1, keepdims=True) + NORM_EPS)
    y_b = (jax.nn.silu(gr.astype(jnp.float32)) * ret.reshape(b, s, R_V)).astype(x.dtype) @ w_b

    merged = jax.nn.sigmoid(ga) * y_a + jax.nn.sigmoid(gb) * y_b
    x = x + merged @ w_o

    h2 = rmsnorm(x, g_ffn)
    x = x + jnp.square(jax.nn.relu(h2 @ w_up)) @ w_down
    return x


def setup_inputs(seed: int = 0) -> dict:
    key = jax.random.key(seed)
    ks = jax.random.split(key, 10)
    f32 = jnp.float32

    def w(k, shape, fan_in):
        return jax.random.normal(k, shape, f32) * (fan_in ** -0.5)

    def gain(k, shape):
        return 1.0 + 0.05 * jax.random.normal(k, shape, f32)

    return {
        "x": jax.random.normal(ks[0], (BATCH, SEQ, D_MODEL), f32),
        "mix_norm": gain(ks[1], (DEPTH, D_MODEL)),
        "w_in": w(ks[2], (DEPTH, D_MODEL, D_IN), D_MODEL),
        "w_a": w(ks[3], (DEPTH, A_OUT, D_MODEL), A_OUT),
        "w_b": w(ks[4], (DEPTH, R_V, D_MODEL), R_V),
        "w_o": w(ks[5], (DEPTH, D_MODEL, D_MODEL), D_MODEL),
        "ffn_norm": gain(ks[6], (DEPTH, D_MODEL)),
        "w_up": w(ks[7], (DEPTH, D_MODEL, D_FF), D_MODEL),
        "w_down": w(ks[8], (DEPTH, D_FF, D_MODEL), D_FF),
        "final_norm": gain(ks[9], (D_MODEL,)),
    }


def reference(x, mix_norm, w_in, w_a, w_b, w_o, ffn_norm, w_up, w_down, final_norm):
    for layer in range(DEPTH):
        x = hybrid_layer(x, mix_norm[layer], w_in[layer], w_a[layer], w_b[layer], w_o[layer],
                         ffn_norm[layer], w_up[layer], w_down[layer])
    return rmsnorm(x, final_norm)
```

```cpp
#include <hip/hip_runtime.h>
#include <hip/hip_cooperative_groups.h>
#include <cstdio>
#include <cstdint>
namespace cg = cooperative_groups;
namespace pg8 {
#define PG8_LAS __attribute__((address_space(3)))
typedef unsigned short bf16_t;
typedef short bf16x8 __attribute__((ext_vector_type(8)));
typedef _Float16 f16x8 __attribute__((ext_vector_type(8)));
typedef float f32x4 __attribute__((ext_vector_type(4)));
typedef unsigned u32x4 __attribute__((ext_vector_type(4)));
constexpr int BM = 256, BK = 64, HALF = 128, HTB = HALF * BK * 2  , STAGE_BYTES = 8 * HTB, NXCD = 8, WGM = 8;

__host__ __device__ __forceinline__ int lds_byte(int r, int c) { const int st = (r >> 4) * 2 + (c >> 5), rr = r & 15, cc = c & 31, ob = rr * 64 + cc * 2; return st * 1024 + (ob ^ (((ob >> 9) & 1) << 5)); }
__host__ __device__ __forceinline__ void stage_rc(int b, int& R, int& C) { const int st = b / 1024, sb = b % 1024, swz = sb ^ (((sb >> 9) & 1) << 5); R = (st >> 1) * 16 + swz / 64; C = (st & 1) * 32 + (swz % 64) / 2; }
__host__ __device__ __forceinline__ int perm32(int rho) { const int n = rho >> 4, i = rho & 15; return 8 * (i >> 2) + 4 * n + (i & 3); }

struct Unit { int pm, pn; };
struct Gemm { const bf16_t* A; const bf16_t* Bt; int M, N, K; };

struct StaticOrder {
    int nM, nN, nwg, G, c;
    __host__ __device__ void init(int M, int N, int G_, int c_) { nM = M / BM; nN = N / BM; nwg = nM * nN; G = G_; c = c_; }
    __host__ __device__ bool next(int i, Unit& u) const {
        const long L = (long)i * G + c; if (L >= nwg) return false;
        int wgid = (int)L; { const int q = nwg / NXCD, r = nwg % NXCD, xcd = wgid % NXCD, off = wgid / NXCD; wgid = (xcd < r ? xcd * (q + 1) : r * (q + 1) + (xcd - r) * q) + off; }
        const int nig = WGM * nN, gid = wgid / nig, fm = gid * WGM, gsz = (nM - fm) < WGM ? (nM - fm) : WGM;
        u.pm = fm + ((wgid % nig) % gsz); u.pn = (wgid % nig) / gsz; return true;
    }
    __device__ __forceinline__ void a_ready(const Unit&) const {}
    __device__ __forceinline__ void done(const Unit&) const {}
};

typedef float f32x2_t __attribute__((ext_vector_type(2))); typedef __bf16 bf16x2_t __attribute__((ext_vector_type(2)));
typedef unsigned u32x2 __attribute__((ext_vector_type(2)));
typedef _Float16 f16x2_t __attribute__((ext_vector_type(2)));
__device__ __forceinline__ unsigned cvtpk(float lo, float hi) { f32x2_t v = {lo, hi}; f16x2_t b = __builtin_convertvector(v, f16x2_t); return __builtin_bit_cast(unsigned, b); }
__device__ __forceinline__ float bflo(unsigned w) { const f16x2_t b = __builtin_bit_cast(f16x2_t, w); return (float)b[0]; }
__device__ __forceinline__ float bfhi(unsigned w) { const f16x2_t b = __builtin_bit_cast(f16x2_t, w); return (float)b[1]; }
__device__ __forceinline__ float sigmoidf_(float x) { return __builtin_amdgcn_rcpf(1.0f + __builtin_amdgcn_exp2f(-1.4426950408889634f * x)); }
__device__ __forceinline__ float row_rstd(const float* part, int row) {
    const f32x4* p = (const f32x4*)(part + (size_t)row * 16);
    const f32x4 a = p[0], b = p[1], c = p[2], d = p[3];
    const float s = (((a[0] + a[1]) + (a[2] + a[3])) + ((b[0] + b[1]) + (b[2] + b[3]))) + (((c[0] + c[1]) + (c[2] + c[3])) + ((d[0] + d[1]) + (d[2] + d[3])));
    return 1.0f / sqrtf(s * (1.0f / 1024.0f) + 1e-6f);
}
__device__ __forceinline__ void rows_rstd(const float* part, int row0, int fq, float (&rs)[2][4]) {
    f32x4 pv[2][4];
#pragma unroll
    for (int ai = 0; ai < 2; ++ai)
#pragma unroll
        for (int m = 0; m < 4; ++m) pv[ai][m] = *(const f32x4*)(part + (size_t)(row0 + ai * HALF + m * 16) * 16 + 4 * fq);
#pragma unroll
    for (int ai = 0; ai < 2; ++ai)
#pragma unroll
        for (int m = 0; m < 4; ++m) { float s = (pv[ai][m][0] + pv[ai][m][1]) + (pv[ai][m][2] + pv[ai][m][3]); s += __shfl_xor(s, 16); s += __shfl_xor(s, 32); rs[ai][m] = 1.0f / sqrtf(s * (1.0f / 1024.0f) + 1e-6f); }
}
constexpr size_t PL_A = 0, PL_QR = (size_t)4 * 3 * 24 * 4096 * 64, PL_QK_SZ = (size_t)4 * 4 * 4096 * 128, PL_VR = PL_QR + 2 * PL_QK_SZ, PL_VG_SZ = (size_t)4 * 4 * 4096 * 256;
struct EpiProj {
    static constexpr bool PERM = true, AFTER_DRAIN = false;
    bf16_t* P; bf16_t* G; const PG8_LAS float* rsl;
    __device__ __forceinline__ void operator()(const f32x4 (&acc)[2][2][4][2], const Unit& u, int wr, int wc, int fr, int fq) const {
        const int row0 = u.pm * BM + wr * 64 + fr; const int pn = u.pn;
        float rs[2][4];
#pragma unroll
        for (int ai = 0; ai < 2; ++ai)
#pragma unroll
            for (int m = 0; m < 4; ++m) rs[ai][m] = rsl[ai * HALF + wr * 64 + m * 16 + fr];
#pragma unroll
        for (int ai = 0; ai < 2; ++ai)
#pragma unroll
            for (int m = 0; m < 4; ++m) { const int row = row0 + ai * HALF + m * 16; const int bl = row >> 12, t = row & 4095;
#pragma unroll
                for (int bj = 0; bj < 2; ++bj) { const f32x4 v0 = acc[ai][bj][m][0] * rs[ai][m], v1 = acc[ai][bj][m][1] * rs[ai][m];
                    u32x4 w; w.x = cvtpk(v0[0], v0[1]); w.y = cvtpk(v0[2], v0[3]); w.z = cvtpk(v1[0], v1[1]); w.w = cvtpk(v1[2], v1[3]);
                    const int ct = bj * HALF + wc * 32 + 8 * fq;
                    bf16_t* dst;
                    if (pn < 18) { const int sect = pn / 6, hh = (pn - sect * 6) * 4 + (ct >> 6), dsh = 2 * (hh >> 3); const int idx = ((t & ((1 << dsh) - 1)) << (12 - dsh)) + (t >> dsh);
                        dst = P + PL_A + ((size_t)((bl * 3 + sect) * 24 + hh) * 4096 + idx) * 64 + (ct & 63); }
                    else if (pn < 22) { const int qk = (pn - 18) >> 1, head = ((pn - 18) & 1) * 2 + (ct >> 7);
                        dst = P + PL_QR + (size_t)qk * PL_QK_SZ + ((size_t)(bl * 4 + head) * 4096 + t) * 128 + (ct & 127); }
                    else if (pn < 30) { const int vg = (pn - 22) >> 2, head = (pn - 22) & 3;
                        dst = P + PL_VR + (size_t)vg * PL_VG_SZ + ((size_t)(bl * 4 + head) * 4096 + t) * 256 + ct; }
                    else dst = G + (size_t)row * 2048 + (pn - 30) * 256 + ct;
                    *(u32x4*)dst = w; } }
    }
};
struct EpiGateA {
    static constexpr bool PERM = true, AFTER_DRAIN = false;
    const bf16_t* G; bf16_t* scr;
    __device__ __forceinline__ void operator()(const f32x4 (&acc)[2][2][4][2], const Unit& u, int wr, int wc, int fr, int fq) const {
        const int row0 = u.pm * BM + wr * 64 + fr, col0 = u.pn * BM + wc * 32 + 8 * fq;
#pragma unroll
        for (int ai = 0; ai < 2; ++ai) { u32x4 gv[4][2];
#pragma unroll
            for (int m = 0; m < 4; ++m)
#pragma unroll
                for (int bj = 0; bj < 2; ++bj) gv[m][bj] = *(const u32x4*)(G + (size_t)(row0 + ai * HALF + m * 16) * 2048 + col0 + bj * HALF);
#pragma unroll
            for (int m = 0; m < 4; ++m) { const int row = row0 + ai * HALF + m * 16;
#pragma unroll
                for (int bj = 0; bj < 2; ++bj) { const int col = col0 + bj * HALF; const u32x4 g = gv[m][bj];
                    f32x4 v0 = acc[ai][bj][m][0], v1 = acc[ai][bj][m][1];
                    v0[0] *= sigmoidf_(bflo(g.x)); v0[1] *= sigmoidf_(bfhi(g.x)); v0[2] *= sigmoidf_(bflo(g.y)); v0[3] *= sigmoidf_(bfhi(g.y));
                    v1[0] *= sigmoidf_(bflo(g.z)); v1[1] *= sigmoidf_(bfhi(g.z)); v1[2] *= sigmoidf_(bflo(g.w)); v1[3] *= sigmoidf_(bfhi(g.w));
                    u32x4 w; w.x = cvtpk(v0[0], v0[1]); w.y = cvtpk(v0[2], v0[3]); w.z = cvtpk(v1[0], v1[1]); w.w = cvtpk(v1[2], v1[3]);
                    *(u32x4*)(scr + (size_t)row * 1024 + col) = w; } }
            asm volatile("" ::: "memory"); }
    }
};
struct EpiGateB {
    static constexpr bool PERM = true, AFTER_DRAIN = false;
    const bf16_t* G; const bf16_t* scr; bf16_t* mrg;
    __device__ __forceinline__ void operator()(const f32x4 (&acc)[2][2][4][2], const Unit& u, int wr, int wc, int fr, int fq) const {
        const int row0 = u.pm * BM + wr * 64 + fr, col0 = u.pn * BM + wc * 32 + 8 * fq;
#pragma unroll
        for (int ai = 0; ai < 2; ++ai) { u32x4 gv[4][2]; u32x4 sv[4][2];
#pragma unroll
            for (int m = 0; m < 4; ++m)
#pragma unroll
                for (int bj = 0; bj < 2; ++bj) { const int row = row0 + ai * HALF + m * 16, col = col0 + bj * HALF;
                    gv[m][bj] = *(const u32x4*)(G + (size_t)row * 2048 + 1024 + col); sv[m][bj] = *(const u32x4*)(scr + (size_t)row * 1024 + col); }
#pragma unroll
            for (int m = 0; m < 4; ++m)
#pragma unroll
                for (int bj = 0; bj < 2; ++bj) { const int row = row0 + ai * HALF + m * 16, col = col0 + bj * HALF; const u32x4 g = gv[m][bj]; const u32x4 sw = sv[m][bj];
                    const f32x4 s0 = (f32x4){bflo(sw.x), bfhi(sw.x), bflo(sw.y), bfhi(sw.y)}, s1 = (f32x4){bflo(sw.z), bfhi(sw.z), bflo(sw.w), bfhi(sw.w)};
                    f32x4 v0 = acc[ai][bj][m][0], v1 = acc[ai][bj][m][1];
                    v0[0] = s0[0] + v0[0] * sigmoidf_(bflo(g.x)); v0[1] = s0[1] + v0[1] * sigmoidf_(bfhi(g.x)); v0[2] = s0[2] + v0[2] * sigmoidf_(bflo(g.y)); v0[3] = s0[3] + v0[3] * sigmoidf_(bfhi(g.y));
                    v1[0] = s1[0] + v1[0] * sigmoidf_(bflo(g.z)); v1[1] = s1[1] + v1[1] * sigmoidf_(bfhi(g.z)); v1[2] = s1[2] + v1[2] * sigmoidf_(bflo(g.w)); v1[3] = s1[3] + v1[3] * sigmoidf_(bfhi(g.w));
                    u32x4 w; w.x = cvtpk(v0[0], v0[1]); w.y = cvtpk(v0[2], v0[3]); w.z = cvtpk(v1[0], v1[1]); w.w = cvtpk(v1[2], v1[3]);
                    *(u32x4*)(mrg + (size_t)row * 1024 + col) = w; }
            asm volatile("" ::: "memory"); }
    }
};
struct EpiResid {
    static constexpr bool PERM = false, AFTER_DRAIN = false;
    bf16_t* xres; float* part;
    __device__ __forceinline__ void operator()(const f32x4 (&acc)[2][2][4][2], const Unit& u, int wr, int wc, int fr, int fq) const {
        const int row0 = u.pm * BM + wr * 64 + fr, col0 = u.pn * BM + wc * 32 + 4 * fq;
#pragma unroll
        for (int ai = 0; ai < 2; ++ai) { u32x2 bs[4][2][2];
#pragma unroll
            for (int m = 0; m < 4; ++m)
#pragma unroll
                for (int bj = 0; bj < 2; ++bj)
#pragma unroll
                    for (int n = 0; n < 2; ++n) bs[m][bj][n] = *(const u32x2*)(xres + (size_t)(row0 + ai * HALF + m * 16) * 1024 + col0 + bj * HALF + n * 16);
#pragma unroll
            for (int m = 0; m < 4; ++m) { const int row = row0 + ai * HALF + m * 16; const size_t off = (size_t)row * 1024 + col0; float ss = 0.f;
#pragma unroll
                for (int bj = 0; bj < 2; ++bj)
#pragma unroll
                    for (int n = 0; n < 2; ++n) { const size_t o2 = off + bj * HALF + n * 16; const u32x2 b = bs[m][bj][n];
                        const f32x4 o = (f32x4){bflo(b.x), bfhi(b.x), bflo(b.y), bfhi(b.y)} + acc[ai][bj][m][n];
                        ss += (o[0] * o[0] + o[1] * o[1]) + (o[2] * o[2] + o[3] * o[3]);
                        u32x2 w; w.x = cvtpk(o[0], o[1]); w.y = cvtpk(o[2], o[3]); *(u32x2*)(xres + o2) = w; }
                ss += __shfl_xor(ss, 16); ss += __shfl_xor(ss, 32);
                if (fq == 0) part[(size_t)row * 16 + u.pn * 4 + wc] = ss; }
            asm volatile("" ::: "memory"); }
    }
};
struct EpiUp {
    static constexpr bool PERM = true, AFTER_DRAIN = false;
    bf16_t* H; const float* part;
    __device__ __forceinline__ void operator()(const f32x4 (&acc)[2][2][4][2], const Unit& u, int wr, int wc, int fr, int fq) const {
        const int row0 = u.pm * BM + wr * 64 + fr, col0 = u.pn * BM + wc * 32 + 8 * fq;
        float rs[2][4]; rows_rstd(part, row0, fq, rs);
#pragma unroll
        for (int ai = 0; ai < 2; ++ai)
#pragma unroll
            for (int m = 0; m < 4; ++m) { const int row = row0 + ai * HALF + m * 16; bf16_t* rowp = H + (size_t)row * 4096 + col0;
#pragma unroll
                for (int bj = 0; bj < 2; ++bj) { f32x4 v0 = acc[ai][bj][m][0] * rs[ai][m], v1 = acc[ai][bj][m][1] * rs[ai][m];
#pragma unroll
                    for (int e = 0; e < 4; ++e) { const float a = fmaxf(v0[e], 0.f), b = fmaxf(v1[e], 0.f); v0[e] = a * a; v1[e] = b * b; }
                    u32x4 w; w.x = cvtpk(v0[0], v0[1]); w.y = cvtpk(v0[2], v0[3]); w.z = cvtpk(v1[0], v1[1]); w.w = cvtpk(v1[2], v1[3]);
                    *(u32x4*)(rowp + bj * HALF) = w; } }
    }
};

template <class Epi, class Sched, bool ALIGN_EPI = false, bool SP2 = false>
__device__ __forceinline__ void gemm_phase(PG8_LAS unsigned char* lds, const Gemm g, const Sched& S, const Epi& E) {
    int tid_l = threadIdx.x; asm volatile("" : "+v"(tid_l));
    const int tid = tid_l, wid = __builtin_amdgcn_readfirstlane(tid >> 6), lane = tid & 63, wr = wid >> 2, wc = wid & 3, fr = lane & 15, fq = lane >> 4;
    const int K = g.K, nt = K / BK;
    unsigned voffA[2], voffB[2];
#pragma unroll
    for (int i = 0; i < 2; ++i) { int R, C; stage_rc(tid * 16 + i * 8192, R, C); const int Rb = Epi::PERM ? ((R & ~31) + perm32(R & 31)) : R;
        voffA[i] = (unsigned)(R * K + C) * 2u; voffB[i] = (unsigned)(Rb * K + C) * 2u; }
    const size_t kstep = (size_t)(BK * 2);
    const size_t hstep = (size_t)HALF * K * 2;
    const size_t tstep = 2 * hstep;
    const unsigned ldsw = (unsigned)wid * 1024u;
    const int aoff = lds_byte(wr * 64 + fr, fq * 8), boff = lds_byte(wc * 32 + fr, fq * 8);
#define PG8_SA(b, h) (((b) * 2 + (h)) * HTB)
#define PG8_SB(b, h) ((4 + (b) * 2 + (h)) * HTB)
#define PG8_STAGE(bufoff, gbase, voff) do { _Pragma("unroll") for (int _i = 0; _i < 2; ++_i) \
        __builtin_amdgcn_global_load_lds((const unsigned*)((const char*)(gbase) + (voff)[_i]), (PG8_LAS unsigned*)(lds + (bufoff) + ldsw + _i * 8192), 16, 0, 0); } while (0)
#define PG8_LDA(dst, b, h) do { _Pragma("unroll") for (int m = 0; m < 4; ++m) _Pragma("unroll") for (int k = 0; k < 2; ++k) dst[m][k] = *(const PG8_LAS bf16x8*)(lds + PG8_SA(b, h) + aoff + m * 2048 + k * 1024); } while (0)
#define PG8_LDB(dst, b, h) do { _Pragma("unroll") for (int n = 0; n < 2; ++n) _Pragma("unroll") for (int k = 0; k < 2; ++k) dst[n][k] = *(const PG8_LAS bf16x8*)(lds + PG8_SB(b, h) + boff + n * 2048 + k * 1024); } while (0)
#define PG8_MMA(ai, bj, At, Bt) do { __builtin_amdgcn_s_setprio(1); _Pragma("unroll") for (int m = 0; m < 4; ++m) _Pragma("unroll") for (int n = 0; n < 2; ++n) _Pragma("unroll") for (int k = 0; k < 2; ++k) \
        acc[ai][bj][m][n] = __builtin_amdgcn_mfma_f32_16x16x32_f16(__builtin_bit_cast(f16x8, Bt[n][k]), __builtin_bit_cast(f16x8, At[m][k]), acc[ai][bj][m][n], 0, 0, 0); __builtin_amdgcn_s_setprio(0); } while (0)
#define PG8_WAIT_V(n) asm volatile("s_waitcnt vmcnt(" #n ")" ::: "memory")
#define PG8_WAIT_L(n) asm volatile("s_waitcnt lgkmcnt(" #n ")" ::: "memory")
#define PG8_BAR __builtin_amdgcn_s_barrier()
#define PG8_SCHED __builtin_amdgcn_sched_barrier(0)
    Unit cur, nxt; int ui = 0;
    if (!S.next(0, cur)) return;
    f32x4 acc[2][2][4][2];
#pragma unroll
    for (int a = 0; a < 2; ++a)
#pragma unroll
        for (int b = 0; b < 2; ++b)
#pragma unroll
            for (int m = 0; m < 4; ++m)
#pragma unroll
                for (int n = 0; n < 2; ++n) acc[a][b][m][n] = (f32x4){0.f, 0.f, 0.f, 0.f};
    bf16x8 At[4][2], B0[2][2], B1[2][2];
    const char* cA = (const char*)g.A + (size_t)cur.pm * tstep; const char* cB = (const char*)g.Bt + (size_t)cur.pn * tstep;
    S.a_ready(cur);
    if constexpr (SP2) {
        PG8_STAGE(PG8_SB(0, 0), cB, voffB); PG8_STAGE(PG8_SB(0, 1), cB + hstep, voffB); PG8_STAGE(PG8_SA(0, 0), cA, voffA); PG8_STAGE(PG8_SA(0, 1), cA + hstep, voffA);
        if (wr == 1) PG8_BAR;
        PG8_WAIT_V(2); PG8_BAR;
        PG8_STAGE(PG8_SB(1, 0), cB + kstep, voffB); PG8_STAGE(PG8_SA(1, 0), cA + kstep, voffA); PG8_STAGE(PG8_SB(1, 1), cB + hstep + kstep, voffB);
        PG8_WAIT_V(6); PG8_BAR;
    } else {
        PG8_STAGE(PG8_SB(0, 0), cB, voffB); PG8_STAGE(PG8_SA(0, 0), cA, voffA); PG8_STAGE(PG8_SB(0, 1), cB + hstep, voffB); PG8_STAGE(PG8_SA(0, 1), cA + hstep, voffA);
        if (wr == 1) PG8_BAR;
        PG8_WAIT_V(4); PG8_BAR;
        PG8_STAGE(PG8_SB(1, 0), cB + kstep, voffB); PG8_STAGE(PG8_SA(1, 0), cA + kstep, voffA); PG8_STAGE(PG8_SB(1, 1), cB + hstep + kstep, voffB);
        PG8_WAIT_V(6); PG8_BAR;
    }
    for (;;) {
        const bool has_next = S.next(ui + 1, nxt);
        const char* nA = has_next ? (const char*)g.A + (size_t)nxt.pm * tstep : cA; const char* nB = has_next ? (const char*)g.Bt + (size_t)nxt.pn * tstep : cB;
        for (int t = 0; t < nt; t += 2) {
            const bool last = (t == nt - 2);
            const char* a1 = cA + (size_t)(t + 1) * kstep;
            const char* a2 = last ? nA : cA + (size_t)(t + 2) * kstep; const char* b2 = last ? nB : cB + (size_t)(t + 2) * kstep;
            const char* a3 = a2 + kstep; const char* b3 = b2 + kstep;
            if (last && has_next) S.a_ready(nxt);
            if constexpr (SP2) {
            PG8_LDB(B0, 0, 0); PG8_LDB(B1, 0, 1); PG8_SCHED; PG8_LDA(At, 0, 0); PG8_STAGE(PG8_SA(1, 1), a1 + hstep, voffA);
            PG8_WAIT_V(8); PG8_WAIT_L(0); PG8_BAR; PG8_MMA(0, 0, At, B0); PG8_MMA(0, 1, At, B1); PG8_BAR; PG8_SCHED;
            PG8_LDA(At, 0, 1); PG8_STAGE(PG8_SB(0, 0), b2, voffB); PG8_STAGE(PG8_SB(0, 1), b2 + hstep, voffB); PG8_STAGE(PG8_SA(0, 0), a2, voffA);
            PG8_WAIT_V(8); PG8_WAIT_L(0); PG8_BAR; PG8_MMA(1, 0, At, B0); PG8_MMA(1, 1, At, B1); PG8_BAR; PG8_SCHED;
            PG8_LDB(B0, 1, 0); PG8_LDB(B1, 1, 1); PG8_SCHED; PG8_LDA(At, 1, 0); PG8_STAGE(PG8_SA(0, 1), a2 + hstep, voffA);
            PG8_WAIT_V(8); PG8_WAIT_L(0); PG8_BAR; PG8_MMA(0, 0, At, B0); PG8_MMA(0, 1, At, B1); PG8_BAR; PG8_SCHED;
            PG8_LDA(At, 1, 1); PG8_STAGE(PG8_SB(1, 0), b3, voffB); PG8_STAGE(PG8_SB(1, 1), b3 + hstep, voffB); PG8_STAGE(PG8_SA(1, 0), a3, voffA);
            PG8_WAIT_V(8); PG8_WAIT_L(0); PG8_BAR; PG8_MMA(1, 0, At, B0); PG8_MMA(1, 1, At, B1); PG8_BAR; PG8_SCHED;
            } else {
            PG8_LDB(B0, 0, 0); PG8_SCHED; PG8_LDA(At, 0, 0); PG8_STAGE(PG8_SA(1, 1), a1 + hstep, voffA);
            PG8_WAIT_L(8); PG8_BAR; PG8_WAIT_L(0); PG8_MMA(0, 0, At, B0); PG8_BAR; PG8_SCHED;
            PG8_LDB(B1, 0, 1); PG8_STAGE(PG8_SB(0, 0), b2, voffB);
            PG8_BAR; PG8_WAIT_L(0); PG8_MMA(0, 1, At, B1); PG8_BAR;
            PG8_LDA(At, 0, 1); PG8_STAGE(PG8_SA(0, 0), a2, voffA);
            PG8_BAR; PG8_WAIT_L(0); PG8_MMA(1, 0, At, B0); PG8_BAR; PG8_SCHED;
            PG8_STAGE(PG8_SB(0, 1), b2 + hstep, voffB);
            PG8_WAIT_V(6); PG8_BAR; PG8_MMA(1, 1, At, B1); PG8_BAR;
            PG8_LDB(B0, 1, 0); PG8_SCHED; PG8_LDA(At, 1, 0); PG8_STAGE(PG8_SA(0, 1), a2 + hstep, voffA);
            PG8_WAIT_L(8); PG8_BAR; PG8_WAIT_L(0); PG8_MMA(0, 0, At, B0); PG8_BAR; PG8_SCHED;
            PG8_LDB(B1, 1, 1); PG8_STAGE(PG8_SB(1, 0), b3, voffB);
            PG8_BAR; PG8_WAIT_L(0); PG8_MMA(0, 1, At, B1); PG8_BAR;
            PG8_LDA(At, 1, 1); PG8_STAGE(PG8_SA(1, 0), a3, voffA);
            PG8_BAR; PG8_WAIT_L(0); PG8_MMA(1, 0, At, B0); PG8_BAR; PG8_SCHED;
            PG8_STAGE(PG8_SB(1, 1), b3 + hstep, voffB);
            PG8_WAIT_V(6); PG8_BAR; PG8_MMA(1, 1, At, B1); PG8_BAR;
            }
        }
        if constexpr (ALIGN_EPI) { if (wr == 0) PG8_BAR; }
        if constexpr (!Epi::AFTER_DRAIN) { E(acc, cur, wr, wc, fr, fq); S.done(cur); }
        if (!has_next) break;
#pragma unroll
        for (int a = 0; a < 2; ++a)
#pragma unroll
            for (int b = 0; b < 2; ++b)
#pragma unroll
                for (int m = 0; m < 4; ++m)
#pragma unroll
                    for (int n = 0; n < 2; ++n) acc[a][b][m][n] = (f32x4){0.f, 0.f, 0.f, 0.f};
        cur = nxt; cA = nA; cB = nB; ++ui;
        if constexpr (ALIGN_EPI) { if (wr == 1) PG8_BAR; }
    }
    PG8_WAIT_V(0);
    if constexpr (!ALIGN_EPI) { if (wr == 0) PG8_BAR; }
    PG8_BAR;
    if constexpr (Epi::AFTER_DRAIN) { E.fused(acc, cur, wr, wc, fr, fq, lds, wid, lane); S.done(cur); }
#undef PG8_SA
#undef PG8_SB
#undef PG8_STAGE
#undef PG8_LDA
#undef PG8_LDB
#undef PG8_MMA
#undef PG8_WAIT_V
#undef PG8_WAIT_L
#undef PG8_BAR
#undef PG8_SCHED
}
}

#define GAS __attribute__((address_space(1)))
#define LAS __attribute__((address_space(3)))
typedef unsigned short bf16;
typedef unsigned u32x4 __attribute__((ext_vector_type(4)));
typedef unsigned u32x2 __attribute__((ext_vector_type(2)));
typedef float f32x4 __attribute__((ext_vector_type(4)));
typedef float f32x16 __attribute__((ext_vector_type(16)));
typedef short bf16x8 __attribute__((ext_vector_type(8)));
typedef short s16x4 __attribute__((ext_vector_type(4)));
using pg8::cvtpk; using pg8::bflo; using pg8::bfhi; using pg8::sigmoidf_; using pg8::PL_A; using pg8::PL_QR; using pg8::PL_QK_SZ; using pg8::PL_VR; using pg8::PL_VG_SZ;

constexpr int NB = 8, SEQ = 4096, DM = 1024, M = NB * SEQ, MG = M / 2, DIN = 9728, DFF = 4096;
constexpr int PW = 7680, GW = 2048;
constexpr int C_QA = 0, C_KA = 1536, C_VA = 3072, C_QR = 4608, C_KR = 5120, C_VR = 5632, C_GR = 6656;
constexpr int NWAVES = 8, NTHR = 512;
constexpr size_t MiB = 1u << 20;
constexpr size_t WS_CTL = 0, CTL_BYTES = 32768, WS_BAR = 4096;
constexpr size_t WS_ROPEA = 64 * 1024;
constexpr size_t WS_ROPER = 1 * MiB;
constexpr size_t WS_PART = 3 * MiB;
constexpr size_t WS_LSE = 5 * MiB;
constexpr size_t WS_W = 8 * MiB, W_LAYER = 40 * MiB;
constexpr size_t W_IN = 0, W_A = 19 * MiB, W_B = 20 * MiB, W_O = 22 * MiB, W_UP = 24 * MiB, W_DN = 32 * MiB;
constexpr size_t WS_XN = 88 * MiB;
constexpr size_t WS_P = 152 * MiB;
constexpr size_t WS_G = 392 * MiB;
constexpr size_t WS_COMB = 456 * MiB;
constexpr size_t WS_RET = 472 * MiB;
constexpr size_t WS_END = 504 * MiB;
constexpr size_t WS_SCR = 152 * MiB;
constexpr size_t WS_MRG = 216 * MiB;
constexpr size_t WS_H = 152 * MiB;
constexpr int LDS_BYTES = 147456;
constexpr int LDS_BCAST = LDS_BYTES - 64;
constexpr int N_PHASES = 26;

struct Frame { LAS unsigned char* lds; int tid, lane, wave, G; };

__device__ __forceinline__ float wave_sum(float v) {
#pragma unroll
    for (int o = 1; o < 64; o <<= 1) v += __shfl_xor(v, o);
    return v;
}
__device__ __forceinline__ void p0_transpose_item(const float* W, const float* gain, int K, int N, bf16* WT, LAS float* scr, int item, int lane) {
    const int nblk = N / 32, kb = item / nblk, nb = item % nblk, k0 = 64 * kb, n0 = 32 * nb;
    float tv[32];
#pragma unroll
    for (int i = 0; i < 32; ++i) { const int kk = 2 * i + (lane >> 5); tv[i] = W[(size_t)(k0 + kk) * N + n0 + (lane & 31)]; }
    if (gain) {
#pragma unroll
        for (int i = 0; i < 32; ++i) tv[i] *= gain[k0 + 2 * i + (lane >> 5)]; }
#pragma unroll
    for (int i = 0; i < 32; ++i) scr[(2 * i + (lane >> 5)) * 33 + (lane & 31)] = tv[i];
    asm volatile("s_waitcnt lgkmcnt(0)" ::: "memory");
    const int c = lane & 7;
#pragma unroll
    for (int j = 0; j < 4; ++j) { const int n = (lane >> 3) + 8 * j; const LAS float* s = scr + (8 * c) * 33 + n;
        u32x4 o; o.x = cvtpk(s[0 * 33], s[1 * 33]); o.y = cvtpk(s[2 * 33], s[3 * 33]); o.z = cvtpk(s[4 * 33], s[5 * 33]); o.w = cvtpk(s[6 * 33], s[7 * 33]);
        *(u32x4*)(WT + (size_t)(n0 + n) * K + k0 + 8 * c) = o; }
    asm volatile("s_waitcnt lgkmcnt(0)" ::: "memory");
}
__device__ __forceinline__ void sincos_acc(double ang, float& s, float& c) {
    const double q = rint(ang * 0.6366197723675814);
    const double r = (ang - q * 1.5707963267948966) - q * 6.123233995736766e-17;
    const double r2 = r * r;
    const double sp = r * (1.0 + r2 * (-1.0 / 6.0 + r2 * (1.0 / 120.0 + r2 * (-1.0 / 5040.0 + r2 * (1.0 / 362880.0 + r2 * (-1.0 / 39916800.0))))));
    const double cp = 1.0 + r2 * (-0.5 + r2 * (1.0 / 24.0 + r2 * (-1.0 / 720.0 + r2 * (1.0 / 40320.0 + r2 * (-1.0 / 3628800.0 + r2 * (1.0 / 479001600.0))))));
    const int qi = ((int)q) & 3;
    const double ss = (qi == 0) ? sp : (qi == 1) ? cp : (qi == 2) ? -sp : -cp;
    const double cc = (qi == 0) ? cp : (qi == 1) ? -sp : (qi == 2) ? -cp : sp;
    s = (float)ss; c = (float)cc;
}

struct Ptrs {
    const float *x, *mix_norm, *w_in, *w_a, *w_b, *w_o, *ffn_norm, *w_up, *w_down, *final_norm;
    float* out; unsigned char* ws;
};

__device__ __forceinline__ void p0_prologue(const Frame& F, const Ptrs& A) {
    LAS float* scr = (LAS float*)(F.lds + F.wave * 16384);
    const int gw = blockIdx.x * NWAVES + F.wave, NGW = F.G * NWAVES;
    constexpr int I_IN = (DM / 64) * (DIN / 32), I_A = (512 / 64) * (DM / 32), I_B = (DM / 64) * (DM / 32), I_O = I_B, I_UP = (DM / 64) * (DFF / 32), I_DN = (DFF / 64) * (DM / 32);
    constexpr int I_LAYER = I_IN + I_A + I_B + I_O + I_UP + I_DN;
    for (int it = gw; it < 2 * I_LAYER; it += NGW) {
        const int l = it / I_LAYER; int r = it - l * I_LAYER;
        unsigned char* wl = A.ws + WS_W + (size_t)l * W_LAYER;
        if (r < I_IN) { p0_transpose_item(A.w_in + (size_t)l * DM * DIN, A.mix_norm + l * DM, DM, DIN, (bf16*)(wl + W_IN), scr, r, F.lane); continue; } r -= I_IN;
        if (r < I_A) { p0_transpose_item(A.w_a + (size_t)l * 512 * DM, nullptr, 512, DM, (bf16*)(wl + W_A), scr, r, F.lane); continue; } r -= I_A;
        if (r < I_B) { p0_transpose_item(A.w_b + (size_t)l * DM * DM, nullptr, DM, DM, (bf16*)(wl + W_B), scr, r, F.lane); continue; } r -= I_B;
        if (r < I_O) { p0_transpose_item(A.w_o + (size_t)l * DM * DM, nullptr, DM, DM, (bf16*)(wl + W_O), scr, r, F.lane); continue; } r -= I_O;
        if (r < I_UP) { p0_transpose_item(A.w_up + (size_t)l * DM * DFF, A.ffn_norm + l * DM, DM, DFF, (bf16*)(wl + W_UP), scr, r, F.lane); continue; } r -= I_UP;
        p0_transpose_item(A.w_down + (size_t)l * DFF * DM, nullptr, DFF, DM, (bf16*)(wl + W_DN), scr, r, F.lane);
    }
    bf16* XN = (bf16*)(A.ws + WS_XN); float* PART = (float*)(A.ws + WS_PART);
    for (int m0 = 4 * gw; m0 < M; m0 += 4 * NGW) {
        f32x4 v[4][4];
#pragma unroll
        for (int q = 0; q < 4; ++q)
#pragma unroll
            for (int j = 0; j < 4; ++j) v[q][j] = ((const f32x4*)(A.x + (size_t)(m0 + q) * DM) + F.lane)[64 * j];
#pragma unroll
        for (int q = 0; q < 4; ++q) { float s = 0.f; u32x2* o8 = (u32x2*)(XN + (size_t)(m0 + q) * DM) + F.lane;
#pragma unroll
            for (int j = 0; j < 4; ++j) { const f32x4 t = v[q][j]; s += (t[0] * t[0] + t[1] * t[1]) + (t[2] * t[2] + t[3] * t[3]); u32x2 w; w.x = cvtpk(t[0], t[1]); w.y = cvtpk(t[2], t[3]); o8[64 * j] = w; }
            s = wave_sum(s);
            if (F.lane < 16) PART[(size_t)(m0 + q) * 16 + F.lane] = (F.lane == 0) ? s : 0.f; }
    }
    float* ropeA = (float*)(A.ws + WS_ROPEA); float* ropeR = (float*)(A.ws + WS_ROPER);
    const int gt = blockIdx.x * NTHR + F.tid, NGT = F.G * NTHR;
    for (int i = gt; i < SEQ * 8; i += NGT) { const int pos = i >> 3, j = i & 7; const float inv = 1.0f / powf(500000.0f, (float)j / 8.0f); const float ang = (float)pos * inv; float s, c; sincos_acc((double)ang, s, c); ropeA[i] = c; ropeA[SEQ * 8 + i] = s; }
    for (int i = gt; i < SEQ * 64; i += NGT) { const int pos = i >> 6, j = i & 63; const float inv = 1.0f / powf(10000.0f, (float)j / 64.0f); const float ang = (float)pos * inv; float s, c; sincos_acc((double)ang, s, c); ((unsigned*)ropeR)[i] = cvtpk(c, s); }
}

__device__ __forceinline__ int queue_next(unsigned* ctr, LAS unsigned char* lds, int tid) {
    __syncthreads();
    if (tid == 0) *(volatile LAS unsigned*)(lds + LDS_BCAST) = atomicAdd(ctr, 1u);
    __syncthreads();
    return (int)*(volatile LAS unsigned*)(lds + LDS_BCAST);
}

#define MFMA16(a, b, c) __builtin_amdgcn_mfma_f32_16x16x32_f16(__builtin_bit_cast(pg8::f16x8, (a)), __builtin_bit_cast(pg8::f16x8, (b)), (c), 0, 0, 0)
#define MFMA32(a, b, c) __builtin_amdgcn_mfma_f32_32x32x16_f16(__builtin_bit_cast(pg8::f16x8, (a)), __builtin_bit_cast(pg8::f16x8, (b)), (c), 0, 0, 0)
typedef short v4i16_t __attribute__((ext_vector_type(4)));
__device__ __forceinline__ s16x4 trr(LAS unsigned char* p) { return __builtin_bit_cast(s16x4, __builtin_amdgcn_ds_read_tr16_b64_v4i16((LAS v4i16_t*)p)); }
__device__ __forceinline__ bf16x8 cat8(s16x4 lo, s16x4 hi) { return __builtin_shufflevector(lo, hi, 0, 1, 2, 3, 4, 5, 6, 7); }

constexpr int AT_P = 144;
constexpr int AT_Q = 0, AT_K = 128 * AT_P, AT_V = AT_K + 256 * AT_P;
struct AttnU { int bl, g, h, r, n, dsh; };
__device__ __forceinline__ AttnU attn_decode(int u) {
    AttnU a; a.bl = u / 768; const int rem = u - a.bl * 768; const int gh = rem >> 5, rb = rem & 31; a.g = gh >> 3; a.h = gh & 7;
    a.dsh = 2 * a.g; const int nbs = 5 - a.dsh; a.r = rb >> nbs; a.n = rb & ((1 << nbs) - 1); return a;
}
__device__ __forceinline__ void attn_load(int tid, int u, const bf16* P, const float* ropeA, u32x4 (&st)[10], f32x4 (&rc)[4]) {
    const AttnU a = attn_decode(u); const int rstart = a.r << (12 - a.dsh);
#pragma unroll
    for (int it = 0; it < 10; ++it) { const int idx = it * 512 + tid, row = idx >> 3, ch = idx & 7;
        const int sect = it < 2 ? 0 : (it < 6 ? 1 : 2); const int li = row - (sect == 0 ? 0 : (sect == 1 ? 128 : 384));
        const int sub = (sect == 0 ? a.n * 128 : (a.n - 1) * 128) + li;
        u32x4 v = (u32x4){0u, 0u, 0u, 0u};
        if (sub >= 0) v = *(const u32x4*)(P + PL_A + ((size_t)((a.bl * 3 + sect) * 24 + a.g * 8 + a.h) * 4096 + rstart + sub) * 64 + ch * 8);
        st[it] = v; }
    rc[0] = rc[1] = rc[2] = rc[3] = (f32x4){0.f, 0.f, 0.f, 0.f};
    if (tid < 384) { const int sub = (tid < 128) ? (a.n * 128 + tid) : ((a.n - 1) * 128 + tid - 128); const int t = sub >= 0 ? ((sub << a.dsh) + a.r) : 0;
        rc[0] = *(const f32x4*)(ropeA + t * 8); rc[1] = *(const f32x4*)(ropeA + t * 8 + 4); rc[2] = *(const f32x4*)(ropeA + SEQ * 8 + t * 8); rc[3] = *(const f32x4*)(ropeA + SEQ * 8 + t * 8 + 4); }
}
__device__ __forceinline__ void attn_stage(LAS unsigned char* lds, int tid, const u32x4 (&st)[10]) {
#pragma unroll
    for (int it = 0; it < 10; ++it) { const int idx = it * 512 + tid, row = idx >> 3, ch = idx & 7;
        const int sect = it < 2 ? 0 : (it < 6 ? 1 : 2); const int li = row - (sect == 0 ? 0 : (sect == 1 ? 128 : 384));
        *(LAS u32x4*)(lds + (sect == 0 ? AT_Q : (sect == 1 ? AT_K : AT_V)) + li * AT_P + ch * 16) = st[it]; }
}
__device__ __forceinline__ void attn_rotary(LAS unsigned char* lds, int tid, const f32x4 (&rc)[4]) {
    if (tid < 384) { LAS unsigned char* rp = lds + (tid < 128 ? AT_Q + tid * AT_P : AT_K + (tid - 128) * AT_P);
        const u32x4 a = *(LAS u32x4*)rp, b = *(LAS u32x4*)(rp + 16);
        float x1[8] = {bflo(a.x), bfhi(a.x), bflo(a.y), bfhi(a.y), bflo(a.z), bfhi(a.z), bflo(a.w), bfhi(a.w)};
        float x2[8] = {bflo(b.x), bfhi(b.x), bflo(b.y), bfhi(b.y), bflo(b.z), bfhi(b.z), bflo(b.w), bfhi(b.w)};
        float cs[8] = {rc[0][0], rc[0][1], rc[0][2], rc[0][3], rc[1][0], rc[1][1], rc[1][2], rc[1][3]}, sn[8] = {rc[2][0], rc[2][1], rc[2][2], rc[2][3], rc[3][0], rc[3][1], rc[3][2], rc[3][3]};
        float o1[8], o2[8];
#pragma unroll
        for (int j = 0; j < 8; ++j) { o1[j] = x1[j] * cs[j] - x2[j] * sn[j]; o2[j] = x1[j] * sn[j] + x2[j] * cs[j]; }
        u32x4 oa, ob; oa.x = cvtpk(o1[0], o1[1]); oa.y = cvtpk(o1[2], o1[3]); oa.z = cvtpk(o1[4], o1[5]); oa.w = cvtpk(o1[6], o1[7]);
        ob.x = cvtpk(o2[0], o2[1]); ob.y = cvtpk(o2[2], o2[3]); ob.z = cvtpk(o2[4], o2[5]); ob.w = cvtpk(o2[6], o2[7]);
        *(LAS u32x4*)rp = oa; *(LAS u32x4*)(rp + 16) = ob; }
}
__device__ __forceinline__ void attn_compute(LAS unsigned char* lds, int lane, int w, int u, bf16* P, float* LSE, bool do_store) {
    const AttnU au = attn_decode(u); const int n = au.n, dsh = au.dsh, r = au.r, g = au.g, h = au.h;
    const size_t rowb = (size_t)au.bl * SEQ;
    const int fr = lane & 15, fq = lane >> 4;
    bf16x8 qf[2];
#pragma unroll
    for (int ks = 0; ks < 2; ++ks) qf[ks] = *(LAS bf16x8*)(lds + AT_Q + (16 * w + fr) * AT_P + (32 * ks + 8 * fq) * 2);
    f32x4 sc[10];
#pragma unroll
    for (int tt = 0; tt < 10; ++tt) { const int t = (w + tt) < 15 ? (w + tt) : 15; f32x4 a = (f32x4){0.f, 0.f, 0.f, 0.f};
#pragma unroll
        for (int ks = 0; ks < 2; ++ks) { const bf16x8 kf = *(LAS bf16x8*)(lds + AT_K + (16 * t + fr) * AT_P + (32 * ks + 8 * fq) * 2); a = MFMA16(kf, qf[ks], a); }
        sc[tt] = a; if (tt & 1) __builtin_amdgcn_sched_barrier(0); }
    float mx = -3.0e38f;
#pragma unroll
    for (int tt = 0; tt < 10; ++tt)
#pragma unroll
        for (int i = 0; i < 4; ++i) { const int kr = 16 * tt + 4 * fq + i; const bool valid = (kr >= fr) && (kr <= fr + 128) && (n > 0 || (16 * w + kr >= 128));
            const float s = valid ? sc[tt][i] : -3.0e38f; sc[tt][i] = s; mx = fmaxf(mx, s); }
    mx = fmaxf(mx, __shfl_xor(mx, 16)); mx = fmaxf(mx, __shfl_xor(mx, 32));
    const float cexp = 0.125f * 1.4426950408889634f; float den = 0.f;
#pragma unroll
    for (int tt = 0; tt < 10; ++tt)
#pragma unroll
        for (int i = 0; i < 4; ++i) { const float p = __builtin_amdgcn_exp2f((sc[tt][i] - mx) * cexp); sc[tt][i] = p; den += p; }
    den += __shfl_xor(den, 16); den += __shfl_xor(den, 32);
    f32x4 o[4];
#pragma unroll
    for (int dt = 0; dt < 4; ++dt) o[dt] = (f32x4){0.f, 0.f, 0.f, 0.f};
    const int tq = fr >> 2, tp = fr & 3;
#pragma unroll
    for (int s = 0; s < 5; ++s) { const int t0 = (w + 2 * s) < 15 ? (w + 2 * s) : 15, t1 = (w + 2 * s + 1) < 15 ? (w + 2 * s + 1) : 15;
        u32x4 pw; pw.x = cvtpk(sc[2 * s][0], sc[2 * s][1]); pw.y = cvtpk(sc[2 * s][2], sc[2 * s][3]); pw.z = cvtpk(sc[2 * s + 1][0], sc[2 * s + 1][1]); pw.w = cvtpk(sc[2 * s + 1][2], sc[2 * s + 1][3]);
        const bf16x8 pf = __builtin_bit_cast(bf16x8, pw);
#pragma unroll
        for (int dt = 0; dt < 4; ++dt) { const s16x4 lo = trr(lds + AT_V + (16 * t0 + 4 * fq + tq) * AT_P + (16 * dt + 4 * tp) * 2), hi = trr(lds + AT_V + (16 * t1 + 4 * fq + tq) * AT_P + (16 * dt + 4 * tp) * 2);
            o[dt] = MFMA16(cat8(lo, hi), pf, o[dt]); } __builtin_amdgcn_sched_barrier(0); }
    if (!do_store) return;
    const float inv = 1.0f / den; const int tquery = ((n * 128 + 16 * w + fr) << dsh) + r; const size_t grow = rowb + tquery;
#pragma unroll
    for (int dt = 0; dt < 4; ++dt) { u32x2 wv; wv.x = cvtpk(o[dt][0] * inv, o[dt][1] * inv); wv.y = cvtpk(o[dt][2] * inv, o[dt][3] * inv);
        *(u32x2*)(P + PL_A + ((size_t)((au.bl * 3) * 24 + g * 8 + h) * 4096 + (r << (12 - dsh)) + n * 128 + 16 * w + fr) * 64 + 16 * dt + 4 * fq) = wv; }
    if (fq == 0) LSE[grow * 24 + g * 8 + h] = mx * 0.125f + __builtin_amdgcn_logf(den) * 0.6931471805599453f;
}

__device__ __forceinline__ void combine_rows(const Frame& F, int r0, int r1, const bf16* P, const float* LSE, bf16* COMB) {
    const int lane = F.lane, h = lane >> 3;
    for (int row = r0 + F.wave; row < r1; row += NWAVES) {
        const float l0 = LSE[(size_t)row * 24 + h], l1 = LSE[(size_t)row * 24 + 8 + h], l2 = LSE[(size_t)row * 24 + 16 + h];
        const float mx = fmaxf(l0, fmaxf(l1, l2));
        float e0 = __builtin_amdgcn_exp2f((l0 - mx) * 1.4426950408889634f), e1 = __builtin_amdgcn_exp2f((l1 - mx) * 1.4426950408889634f), e2 = __builtin_amdgcn_exp2f((l2 - mx) * 1.4426950408889634f);
        const float inv = 1.0f / (e0 + e1 + e2); e0 *= inv; e1 *= inv; e2 *= inv;
        const int bl = row >> 12, t = row & 4095, ch = lane & 7;
        const bf16* hb = P + PL_A + ((size_t)(bl * 3 * 24 + h) * 4096) * 64 + ch * 8;
        const u32x4 a = *(const u32x4*)(hb + (size_t)t * 64), b = *(const u32x4*)(hb + ((size_t)8 * 4096 + ((t & 3) << 10) + (t >> 2)) * 64), c = *(const u32x4*)(hb + ((size_t)16 * 4096 + ((t & 15) << 8) + (t >> 4)) * 64);
        u32x4 o;
        o.x = cvtpk(e0 * bflo(a.x) + e1 * bflo(b.x) + e2 * bflo(c.x), e0 * bfhi(a.x) + e1 * bfhi(b.x) + e2 * bfhi(c.x));
        o.y = cvtpk(e0 * bflo(a.y) + e1 * bflo(b.y) + e2 * bflo(c.y), e0 * bfhi(a.y) + e1 * bfhi(b.y) + e2 * bfhi(c.y));
        o.z = cvtpk(e0 * bflo(a.z) + e1 * bflo(b.z) + e2 * bflo(c.z), e0 * bfhi(a.z) + e1 * bfhi(b.z) + e2 * bfhi(c.z));
        o.w = cvtpk(e0 * bflo(a.w) + e1 * bflo(b.w) + e2 * bflo(c.w), e0 * bfhi(a.w) + e1 * bfhi(b.w) + e2 * bfhi(c.w));
        *(u32x4*)(COMB + (size_t)row * 512 + lane * 8) = o;
    }
}

constexpr int RT_QP = 272, RT_VP = 528;
constexpr int RT_Q = 0, RT_K = 128 * RT_QP, RT_V = 2 * 128 * RT_QP, RT_RED = RT_V + 128 * RT_VP;
__device__ __forceinline__ int crow(int i, int hh) { return (i & 3) + 8 * (i >> 2) + 4 * hh; }
__device__ __forceinline__ bf16x8 trfrag(LAS unsigned char* base, int pitch, int row0, int col0, int tq, int tp) {
    const s16x4 lo = trr(base + (row0 + tq) * pitch + (col0 + 4 * tp) * 2), hi = trr(base + (row0 + 4 + tq) * pitch + (col0 + 4 * tp) * 2);
    return cat8(lo, hi);
}
constexpr int NSEG = 16, NCS = 32 / NSEG;
__device__ __forceinline__ void ret_pass1(const Frame& F, int bl, int h, int seg, const bf16* P, float* Lbuf, const float* ropeR) {
    LAS unsigned char* lds = F.lds; const int w = F.wave;
    const float l2g = (h == 0) ? -0.04580368961312479f : (h == 1) ? -0.02272007650008353f : (h == 2) ? -0.011315313227834146f : -0.005646563141142062f;
    const float adec = __builtin_amdgcn_exp2f(128.0f * l2g);
    const size_t rowb = (size_t)bl * SEQ; const size_t hrow0 = (size_t)(bl * 4 + h) * 4096;
    f32x16 Sacc[4];
#pragma unroll
    for (int kt = 0; kt < 4; ++kt)
#pragma unroll
        for (int i = 0; i < 16; ++i) Sacc[kt][i] = 0.f;
    for (int c = seg * NCS; c < seg * NCS + NCS; ++c) {
        int tid = F.tid; asm volatile("" : "+v"(tid));
        const int lane = tid & 63, hh = lane >> 5, blk = (lane >> 4) & 1, tq = (lane & 15) >> 2, tp = lane & 3;
        const size_t crow0 = rowb + (size_t)c * 128;
#pragma unroll
        for (int it = 0; it < 2; ++it) { const int id = it * 512 + tid, row = id >> 3, ch = id & 7;
            const bf16* src = P + PL_QR + PL_QK_SZ + (hrow0 + (size_t)c * 128 + row) * 128 + ch * 8;
            const u32x4 a = *(const u32x4*)src, b = *(const u32x4*)(src + 64);
            const int pos = c * 128 + row; const unsigned* tp = (const unsigned*)ropeR + pos * 64 + ch * 8;
            const u32x4 t0v = *(const u32x4*)tp, t1v = *(const u32x4*)(tp + 4);
            float x1[8] = {bflo(a.x), bfhi(a.x), bflo(a.y), bfhi(a.y), bflo(a.z), bfhi(a.z), bflo(a.w), bfhi(a.w)};
            float x2[8] = {bflo(b.x), bfhi(b.x), bflo(b.y), bfhi(b.y), bflo(b.z), bfhi(b.z), bflo(b.w), bfhi(b.w)};
            float cs[8] = {bflo(t0v.x), bflo(t0v.y), bflo(t0v.z), bflo(t0v.w), bflo(t1v.x), bflo(t1v.y), bflo(t1v.z), bflo(t1v.w)}, sn[8] = {bfhi(t0v.x), bfhi(t0v.y), bfhi(t0v.z), bfhi(t0v.w), bfhi(t1v.x), bfhi(t1v.y), bfhi(t1v.z), bfhi(t1v.w)};
            const float sc = 0.08838834764831845f * __builtin_amdgcn_exp2f(l2g * (float)(127 - row)); float o1[8], o2[8];
#pragma unroll
            for (int j = 0; j < 8; ++j) { o1[j] = (x1[j] * cs[j] - x2[j] * sn[j]) * sc; o2[j] = (x1[j] * sn[j] + x2[j] * cs[j]) * sc; }
            u32x4 oa, ob; oa.x = cvtpk(o1[0], o1[1]); oa.y = cvtpk(o1[2], o1[3]); oa.z = cvtpk(o1[4], o1[5]); oa.w = cvtpk(o1[6], o1[7]);
            ob.x = cvtpk(o2[0], o2[1]); ob.y = cvtpk(o2[2], o2[3]); ob.z = cvtpk(o2[4], o2[5]); ob.w = cvtpk(o2[6], o2[7]);
            LAS unsigned char* dp = lds + RT_K + row * RT_QP + ch * 16;
            *(LAS u32x4*)dp = oa; *(LAS u32x4*)(dp + 128) = ob; }
#pragma unroll
        for (int it = 0; it < 8; ++it) { const int idx = it * 512 + tid, row = idx >> 5, ch = idx & 31;
            const u32x4 v = *(const u32x4*)(P + PL_VR + (hrow0 + (size_t)c * 128 + row) * 256 + ch * 8);
            *(LAS u32x4*)(lds + RT_V + row * RT_VP + ch * 16) = v; }
        __syncthreads();
#pragma unroll
        for (int kt = 0; kt < 4; ++kt)
#pragma unroll
            for (int i = 0; i < 16; ++i) Sacc[kt][i] *= adec;
#pragma unroll
        for (int ks = 0; ks < 8; ++ks) { const bf16x8 vf = trfrag(lds + RT_V, RT_VP, 16 * ks + 8 * hh, 32 * w + 16 * blk, tq, tp);
#pragma unroll
            for (int kt = 0; kt < 4; ++kt) { const bf16x8 kf = trfrag(lds + RT_K, RT_QP, 16 * ks + 8 * hh, 32 * kt + 16 * blk, tq, tp); Sacc[kt] = MFMA32(kf, vf, Sacc[kt]); } }
        __syncthreads();
    }
    unsigned* Lp = (unsigned*)Lbuf + ((size_t)((bl * 4 + h) * NSEG + seg) * 8 + w) * 2048 + F.lane;
#pragma unroll
    for (int kt = 0; kt < 4; ++kt)
#pragma unroll
        for (int i = 0; i < 8; ++i) Lp[(kt * 8 + i) * 64] = cvtpk(Sacc[kt][2 * i], Sacc[kt][2 * i + 1]);
}
__device__ __forceinline__ void ret_unit(const Frame& F, int bl, int h, int seg, const bf16* P, bf16* RET, const float* Lbuf, const float* ropeR) {
    const int c0 = seg * NCS, c1 = c0 + NCS;
    LAS unsigned char* lds = F.lds; const int w = F.wave;
    const float l2g = (h == 0) ? -0.04580368961312479f : (h == 1) ? -0.02272007650008353f : (h == 2) ? -0.011315313227834146f : -0.005646563141142062f;
    const float adec = __builtin_amdgcn_exp2f(128.0f * l2g);
    const size_t rowb = (size_t)bl * SEQ; const size_t hrow0 = (size_t)(bl * 4 + h) * 4096;
    f32x16 Sacc[4], out[4];
#pragma unroll
    for (int kt = 0; kt < 4; ++kt)
#pragma unroll
        for (int i = 0; i < 16; ++i) Sacc[kt][i] = 0.f;
    { const float aseg = __builtin_amdgcn_exp2f(128.0f * (float)NCS * l2g);
      const unsigned* Lb = (const unsigned*)Lbuf + ((size_t)((bl * 4 + h) * NSEG) * 8 + w) * 2048 + F.lane; int sp = 0;
      for (; sp + 2 < seg; sp += 3) { const unsigned* L0 = Lb + (size_t)sp * 8 * 2048; unsigned t[3][32];
#pragma unroll
        for (int q = 0; q < 3; ++q)
#pragma unroll
            for (int j = 0; j < 32; ++j) t[q][j] = L0[(size_t)q * 8 * 2048 + j * 64];
#pragma unroll
        for (int q = 0; q < 3; ++q)
#pragma unroll
            for (int kt = 0; kt < 4; ++kt)
#pragma unroll
                for (int i = 0; i < 8; ++i) { Sacc[kt][2 * i] = Sacc[kt][2 * i] * aseg + bflo(t[q][kt * 8 + i]); Sacc[kt][2 * i + 1] = Sacc[kt][2 * i + 1] * aseg + bfhi(t[q][kt * 8 + i]); } }
      for (; sp < seg; ++sp) { const unsigned* L0 = Lb + (size_t)sp * 8 * 2048; unsigned t[32];
#pragma unroll
        for (int j = 0; j < 32; ++j) t[j] = L0[j * 64];
#pragma unroll
        for (int kt = 0; kt < 4; ++kt)
#pragma unroll
            for (int i = 0; i < 8; ++i) { Sacc[kt][2 * i] = Sacc[kt][2 * i] * aseg + bflo(t[kt * 8 + i]); Sacc[kt][2 * i + 1] = Sacc[kt][2 * i + 1] * aseg + bfhi(t[kt * 8 + i]); } } }
    for (int c = c0; c < c1; ++c) {
        int tid = F.tid; asm volatile("" : "+v"(tid));
        const int lane = tid & 63, r = lane & 31, hh = lane >> 5, blk = (lane >> 4) & 1, tq = (lane & 15) >> 2, tp = lane & 3;
        const size_t crow0 = rowb + (size_t)c * 128;
#pragma unroll
        for (int it = 0; it < 4; ++it) { const int id = (it & 1) * 512 + tid, row = id >> 3, ch = id & 7; const bool isk = it >= 2;
            const bf16* src = P + PL_QR + (isk ? PL_QK_SZ : (size_t)0) + (hrow0 + (size_t)c * 128 + row) * 128 + ch * 8;
            const u32x4 a = *(const u32x4*)src, b = *(const u32x4*)(src + 64);
            const int pos = c * 128 + row; const unsigned* tp = (const unsigned*)ropeR + pos * 64 + ch * 8;
            const u32x4 t0v = *(const u32x4*)tp, t1v = *(const u32x4*)(tp + 4);
            float x1[8] = {bflo(a.x), bfhi(a.x), bflo(a.y), bfhi(a.y), bflo(a.z), bfhi(a.z), bflo(a.w), bfhi(a.w)};
            float x2[8] = {bflo(b.x), bfhi(b.x), bflo(b.y), bfhi(b.y), bflo(b.z), bfhi(b.z), bflo(b.w), bfhi(b.w)};
            float cs[8] = {bflo(t0v.x), bflo(t0v.y), bflo(t0v.z), bflo(t0v.w), bflo(t1v.x), bflo(t1v.y), bflo(t1v.z), bflo(t1v.w)}, sn[8] = {bfhi(t0v.x), bfhi(t0v.y), bfhi(t0v.z), bfhi(t0v.w), bfhi(t1v.x), bfhi(t1v.y), bfhi(t1v.z), bfhi(t1v.w)};
            const float sc = isk ? 0.08838834764831845f : 1.0f; float o1[8], o2[8];
#pragma unroll
            for (int j = 0; j < 8; ++j) { o1[j] = (x1[j] * cs[j] - x2[j] * sn[j]) * sc; o2[j] = (x1[j] * sn[j] + x2[j] * cs[j]) * sc; }
            u32x4 oa, ob; oa.x = cvtpk(o1[0], o1[1]); oa.y = cvtpk(o1[2], o1[3]); oa.z = cvtpk(o1[4], o1[5]); oa.w = cvtpk(o1[6], o1[7]);
            ob.x = cvtpk(o2[0], o2[1]); ob.y = cvtpk(o2[2], o2[3]); ob.z = cvtpk(o2[4], o2[5]); ob.w = cvtpk(o2[6], o2[7]);
            LAS unsigned char* dp = lds + (isk ? RT_K : RT_Q) + row * RT_QP + ch * 16;
            *(LAS u32x4*)dp = oa; *(LAS u32x4*)(dp + 128) = ob; }
#pragma unroll
        for (int it = 0; it < 8; ++it) { const int idx = it * 512 + tid, row = idx >> 5, ch = idx & 31;
            const u32x4 v = *(const u32x4*)(P + PL_VR + (hrow0 + (size_t)c * 128 + row) * 256 + ch * 8);
            *(LAS u32x4*)(lds + RT_V + row * RT_VP + ch * 16) = v; }
        __syncthreads();
        u32x2 gpre[4][4];
#pragma unroll
        for (int pt = 0; pt < 4; ++pt)
#pragma unroll
            for (int gi = 0; gi < 4; ++gi) gpre[pt][gi] = *(const u32x2*)(P + PL_VR + PL_VG_SZ + (hrow0 + (size_t)c * 128 + 32 * pt + r) * 256 + 32 * w + 8 * gi + 4 * hh);
        const int ci = w >> 1, mi0 = 2 * (w & 1);
        unsigned smp[2][8];
#pragma unroll
        for (int t2 = 0; t2 < 2; ++t2) { const int mi = mi0 + t2; f32x16 x;
#pragma unroll
            for (int i = 0; i < 16; ++i) x[i] = 0.f;
            if (mi <= ci) {
#pragma unroll
                for (int ks = 0; ks < 8; ++ks) { const bf16x8 a = *(LAS bf16x8*)(lds + RT_Q + (32 * ci + r) * RT_QP + (16 * ks + 8 * hh) * 2), b = *(LAS bf16x8*)(lds + RT_K + (32 * mi + r) * RT_QP + (16 * ks + 8 * hh) * 2);
                    x = MFMA32(a, b, x); } }
#pragma unroll
            for (int i = 0; i < 16; ++i) { const int dlt = (32 * ci + crow(i, hh)) - (32 * mi + r); x[i] = dlt >= 0 ? x[i] * __builtin_amdgcn_exp2f(l2g * (float)dlt) : 0.f; }
#pragma unroll
            for (int i = 0; i < 8; ++i) smp[t2][i] = cvtpk(x[2 * i], x[2 * i + 1]); }
#pragma unroll
        for (int pt = 0; pt < 4; ++pt)
#pragma unroll
            for (int i = 0; i < 16; ++i) out[pt][i] = 0.f;
#pragma unroll
        for (int kt = 0; kt < 4; ++kt)
#pragma unroll
            for (int s = 0; s < 2; ++s) { u32x4 pw; pw.x = cvtpk(Sacc[kt][8 * s], Sacc[kt][8 * s + 1]); pw.y = cvtpk(Sacc[kt][8 * s + 2], Sacc[kt][8 * s + 3]); pw.z = cvtpk(Sacc[kt][8 * s + 4], Sacc[kt][8 * s + 5]); pw.w = cvtpk(Sacc[kt][8 * s + 6], Sacc[kt][8 * s + 7]);
                const bf16x8 sf = __builtin_bit_cast(bf16x8, pw);
#pragma unroll
                for (int pt = 0; pt < 4; ++pt) { LAS unsigned char* qp = lds + RT_Q + (32 * pt + r) * RT_QP + (32 * kt + 16 * s + 4 * hh) * 2;
                    const s16x4 lo = *(LAS s16x4*)qp, hi = *(LAS s16x4*)(qp + 16);
                    out[pt] = MFMA32(sf, cat8(lo, hi), out[pt]); } __builtin_amdgcn_sched_barrier(0); }
#pragma unroll
        for (int pt = 0; pt < 4; ++pt) { const float xi = __builtin_amdgcn_exp2f(l2g * (float)(32 * pt + r + 1));
#pragma unroll
            for (int i = 0; i < 16; ++i) out[pt][i] *= xi; }
        __syncthreads();
#pragma unroll
        for (int t2 = 0; t2 < 2; ++t2) { const int mi = mi0 + t2;
            if (mi <= ci) {
#pragma unroll
                for (int i = 0; i < 16; ++i) { const unsigned wv = smp[t2][i >> 1]; const unsigned short hv = (i & 1) ? (unsigned short)(wv >> 16) : (unsigned short)(wv & 0xffffu);
                    *(LAS unsigned short*)(lds + RT_Q + (32 * ci + crow(i, hh)) * RT_QP + (32 * mi + r) * 2) = hv; } } }
#pragma unroll
        for (int it = 0; it < 4; ++it) { const int idx = it * 512 + tid, row = idx >> 4, ch = idx & 15; LAS u32x4* kp = (LAS u32x4*)(lds + RT_K + row * RT_QP + ch * 16);
            const u32x4 v = *kp; const float z = __builtin_amdgcn_exp2f(l2g * (float)(127 - row)); u32x4 o;
            o.x = cvtpk(bflo(v.x) * z, bfhi(v.x) * z); o.y = cvtpk(bflo(v.y) * z, bfhi(v.y) * z); o.z = cvtpk(bflo(v.z) * z, bfhi(v.z) * z); o.w = cvtpk(bflo(v.w) * z, bfhi(v.w) * z); *kp = o; }
        __syncthreads();
#pragma unroll
        for (int kt = 0; kt < 4; ++kt)
#pragma unroll
            for (int i = 0; i < 16; ++i) Sacc[kt][i] *= adec;
#pragma unroll
        for (int ks = 0; ks < 8; ++ks) { const bf16x8 vf = trfrag(lds + RT_V, RT_VP, 16 * ks + 8 * hh, 32 * w + 16 * blk, tq, tp);
#pragma unroll
            for (int pt = 0; pt < 4; ++pt) if (ks < 2 * (pt + 1)) { const bf16x8 smf = *(LAS bf16x8*)(lds + RT_Q + (32 * pt + r) * RT_QP + (16 * ks + 8 * hh) * 2); out[pt] = MFMA32(vf, smf, out[pt]); }
#pragma unroll
            for (int kt = 0; kt < 4; ++kt) { const bf16x8 kf = trfrag(lds + RT_K, RT_QP, 16 * ks + 8 * hh, 32 * kt + 16 * blk, tq, tp); Sacc[kt] = MFMA32(kf, vf, Sacc[kt]); } __builtin_amdgcn_sched_barrier(0); }
        LAS float* red = (LAS float*)(lds + RT_RED);
#pragma unroll
        for (int pt = 0; pt < 4; ++pt) { float ss = 0.f;
#pragma unroll
            for (int i = 0; i < 16; ++i) ss += out[pt][i] * out[pt][i];
            ss += __shfl_xor(ss, 32);
            if (hh == 0) red[(32 * pt + r) * 8 + w] = ss; }
        __syncthreads();
#pragma unroll
        for (int pt = 0; pt < 4; ++pt) { const LAS f32x4* rp = (const LAS f32x4*)(red + (32 * pt + r) * 8); const f32x4 a = rp[0], b = rp[1];
            const float tot = ((a[0] + a[1]) + (a[2] + a[3])) + ((b[0] + b[1]) + (b[2] + b[3])); const float rs = 1.0f / sqrtf(tot * (1.0f / 256.0f) + 1e-6f);
            const size_t grow = crow0 + 32 * pt + r;
#pragma unroll
            for (int gi = 0; gi < 4; ++gi) { const int dv0 = 32 * w + 8 * gi + 4 * hh; const u32x2 gv = gpre[pt][gi];
                const float g0 = bflo(gv.x), g1 = bfhi(gv.x), g2 = bflo(gv.y), g3 = bfhi(gv.y);
                u32x2 o; o.x = cvtpk(out[pt][4 * gi] * rs * g0 * sigmoidf_(g0), out[pt][4 * gi + 1] * rs * g1 * sigmoidf_(g1)); o.y = cvtpk(out[pt][4 * gi + 2] * rs * g2 * sigmoidf_(g2), out[pt][4 * gi + 3] * rs * g3 * sigmoidf_(g3));
                *(u32x2*)(RET + grow * 1024 + h * 256 + dv0) = o; } __builtin_amdgcn_sched_barrier(0); }
    }
}

#define XB_TMO      128
#define XB_XCNT(j)  (256  + 64 * (j))
#define XB_XSUB(j)  (1280 + 64 * (j))
#define XB_XGEN(j)  (2304 + 64 * (j))
#define XB_TOP      3328
#define XB_TOPGEN   3392
#define XCD_BAR_WORDS 3456
#define XB_SPIN_CAP (1u << 18)

__device__ __forceinline__ unsigned xb_ld(unsigned* p)              { return __hip_atomic_load(p, __ATOMIC_RELAXED, __HIP_MEMORY_SCOPE_AGENT); }
__device__ __forceinline__ unsigned xb_add(unsigned* p, unsigned v) { return __hip_atomic_fetch_add(p, v, __ATOMIC_RELAXED, __HIP_MEMORY_SCOPE_AGENT); }
__device__ __forceinline__ unsigned xb_xcc_id() { return (unsigned)__builtin_amdgcn_s_getreg((3 << 11) | 20) & 0xFu; }
#define XB_SPIN(cond, bar) do { unsigned _sp = 0; while (cond) { __builtin_amdgcn_s_sleep(1); \
    if ((++_sp & 255u) == 0u) { if (xb_ld(&(bar)[XB_TMO])) break; if (_sp > XB_SPIN_CAP) { atomicAdd(&(bar)[XB_TMO], 1u); break; } } } } while (0)

struct XcdBarrier {
    unsigned* bar; unsigned x;
    volatile LAS unsigned* st;
};

__device__ __forceinline__ XcdBarrier xcd_barrier_post(unsigned* bar, volatile LAS unsigned* st) {
    XcdBarrier b; b.bar = bar; b.x = xb_xcc_id(); b.st = st;
    if (threadIdx.x == 0) (void)xb_add(&bar[XB_XCNT(b.x)], 1u);
    return b;
}
__device__ __forceinline__ void xcd_barrier_complete(unsigned* bar, unsigned x, unsigned& nloc, unsigned& nx) {
    const unsigned G = gridDim.x * gridDim.y * gridDim.z;
    unsigned sum, cnt, mine, sp = 0u;
    for (;;) {
        sum = 0u; cnt = 0u; mine = 0u;
#pragma unroll
        for (unsigned j = 0; j < 16; ++j) { const unsigned c = xb_ld(&bar[XB_XCNT(j)]); sum += c; cnt += (c > 0u) ? 1u : 0u; mine = (j == x) ? c : mine; }
        if (sum == G) break;
        __builtin_amdgcn_s_sleep(1);
        if ((++sp & 255u) == 0u) { if (xb_ld(&bar[XB_TMO])) break; if (sp > XB_SPIN_CAP) { atomicAdd(&bar[XB_TMO], 1u); break; } }
    }
    nloc = mine > 0u ? mine : 1u; nx = cnt > 0u ? cnt : 1u;
}

__device__ __forceinline__ void xcd_barrier(const XcdBarrier& b) {
    asm volatile("s_waitcnt vmcnt(0)" ::: "memory");
    __syncthreads();
    if (threadIdx.x == 0) {
        unsigned* bar = b.bar;
        __builtin_amdgcn_s_waitcnt(0);
        unsigned nloc = b.st[0], nx = b.st[1];
        if (nloc == 0u) { xcd_barrier_complete(bar, b.x, nloc, nx); b.st[0] = nloc; b.st[1] = nx; }
        const unsigned old = xb_add(&bar[XB_XSUB(b.x)], 1u);
        const unsigned gen = old / nloc;
        if (old + 1u == (gen + 1u) * nloc) {
            __builtin_amdgcn_fence(__ATOMIC_RELEASE, "agent");
            asm volatile("s_waitcnt vmcnt(0)" ::: "memory");
            const unsigned og = xb_add(&bar[XB_TOP], 1u);
            const unsigned tg = og / nx;
            if (og + 1u == (tg + 1u) * nx) xb_add(&bar[XB_TOPGEN], 1u);
            else XB_SPIN(xb_ld(&bar[XB_TOPGEN]) == tg, bar);
            __builtin_amdgcn_fence(__ATOMIC_ACQUIRE, "agent");
            xb_add(&bar[XB_XGEN(b.x)], 1u);
            asm volatile("s_waitcnt vmcnt(0)" ::: "memory");
        } else {
            XB_SPIN(xb_ld(&bar[XB_XGEN(b.x)]) == gen, bar);
            __builtin_amdgcn_fence(__ATOMIC_ACQUIRE, "agent");
            asm volatile("s_waitcnt vmcnt(0)" ::: "memory");
        }
    }
    __syncthreads();
}

#ifndef DIS_P0
#define DIS_P0 0
#endif
#ifndef DIS_G1
#define DIS_G1 0
#endif
#ifndef DIS_MIX
#define DIS_MIX 0
#endif
#ifndef DIS_RET
#define DIS_RET 0
#endif
#ifndef DIS_ATT
#define DIS_ATT 0
#endif
#ifndef DIS_CMB
#define DIS_CMB 0
#endif
#ifndef DIS_GY
#define DIS_GY 0
#endif
#ifndef DIS_GO
#define DIS_GO 0
#endif
#ifndef DIS_UP
#define DIS_UP 0
#endif
#ifndef DIS_DN
#define DIS_DN 0
#endif
#ifndef DIS_FIN
#define DIS_FIN 0
#endif
#ifndef REP_P0
#define REP_P0 1
#endif
#ifndef REP_G1
#define REP_G1 1
#endif
#ifndef REP_P2
#define REP_P2 1
#endif
#ifndef REP_P3
#define REP_P3 1
#endif
#ifndef REP_GY
#define REP_GY 1
#endif
#ifndef REP_UP
#define REP_UP 1
#endif
struct Args { const float* in[10]; float* out; unsigned char* ws; int ph_lo, ph_hi; };

__global__ void __launch_bounds__(NTHR, 2) fwd_kernel(Args args) {
    extern __shared__ __attribute__((aligned(16))) unsigned char lds_raw[];
    cg::grid_group grid = cg::this_grid();
    Frame F; F.lds = (LAS unsigned char*)lds_raw; F.tid = threadIdx.x; F.lane = F.tid & 63; F.wave = __builtin_amdgcn_readfirstlane(F.tid >> 6); F.G = gridDim.x;
    Ptrs A; A.x = args.in[0]; A.mix_norm = args.in[1]; A.w_in = args.in[2]; A.w_a = args.in[3]; A.w_b = args.in[4]; A.w_o = args.in[5]; A.ffn_norm = args.in[6]; A.w_up = args.in[7]; A.w_down = args.in[8]; A.final_norm = args.in[9];
    A.out = args.out; A.ws = args.ws;
    unsigned char* ws = args.ws;
    unsigned* ctl = (unsigned*)(ws + WS_CTL);
    bf16* XN = (bf16*)(ws + WS_XN); bf16* Pb = (bf16*)(ws + WS_P); bf16* Gb = (bf16*)(ws + WS_G); bf16* COMB = (bf16*)(ws + WS_COMB); bf16* RET = (bf16*)(ws + WS_RET);
    bf16* SCR = (bf16*)(ws + WS_SCR); bf16* MRG = (bf16*)(ws + WS_MRG); bf16* Hb = (bf16*)(ws + WS_H);
    float* PART = (float*)(ws + WS_PART); float* LSE = (float*)(ws + WS_LSE);
    const float* ropeA = (const float*)(ws + WS_ROPEA); const float* ropeR = (const float*)(ws + WS_ROPER);
    if (F.tid < 8) ((LAS unsigned*)(F.lds + LDS_BYTES - 32))[F.tid] = 0u;
    __syncthreads();
    XcdBarrier bar = xcd_barrier_post((unsigned*)(ws + WS_BAR), (volatile LAS unsigned*)(F.lds + LDS_BYTES - 32));
    const int lo = args.ph_lo, hi = args.ph_hi; int ph = 0;
#define PH_ON (ph >= lo && ph < hi)
#define RELAUNDER do { int t_ = threadIdx.x; asm volatile("" : "+v"(t_)); F.tid = t_; F.lane = t_ & 63; bx = blockIdx.x; asm volatile("" : "+s"(bx)); } while (0)
    int bx = blockIdx.x;
#define PH_END do { if (ph >= lo && ph + 1 < hi) { if (lo < 0) grid.sync(); else xcd_barrier(bar); } ++ph; } while (0)

    if (PH_ON && !DIS_P0) for (int rep = 0; rep < REP_P0; ++rep) p0_prologue(F, A);
    PH_END;
    for (int l = 0; l < 2; ++l) {
        unsigned char* wl = ws + WS_W + (size_t)l * W_LAYER;
        for (int rd = 0; rd < 2; ++rd) {
            const size_t roff = (size_t)rd * MG;
            if (PH_ON && !DIS_G1) {
                RELAUNDER;
                pg8::Gemm g{XN + roff * DM, (const bf16*)(wl + W_IN), MG, DIN, DM}; pg8::StaticOrder S; S.init(MG, DIN, F.G, bx);
                LAS float* rsl = (LAS float*)(F.lds + 131072);
                { pg8::Unit u0; S.next(0, u0);
                  if (F.tid < 256) rsl[F.tid] = pg8::row_rstd(PART + roff * 16, u0.pm * 256 + F.tid);
                  __syncthreads(); }
                pg8::EpiProj E{Pb, Gb, rsl};
                for (int rep = 0; rep < REP_G1; ++rep) { pg8::gemm_phase<pg8::EpiProj, pg8::StaticOrder, true, true>(F.lds, g, S, E); __syncthreads(); }
            }
            PH_END;
            if (PH_ON && !DIS_MIX) {
                RELAUNDER;
                unsigned* ctr = ctl + 16 * (l * 2 + rd);
                float* Lbuf = A.out;
                constexpr int NR1 = 16 * (NSEG - 1);
                for (int rep = 0; rep < REP_P2; ++rep) {
                    const int UEND = NR1 + 3072; volatile LAS unsigned* bc = (volatile LAS unsigned*)(F.lds + LDS_BCAST);
                    int u = queue_next(ctr + rep, F.lds, F.tid);
                    while (u < NR1) { ret_pass1(F, (u & 15) >> 2, u & 3, u >> 4, Pb, Lbuf, ropeR); u = queue_next(ctr + rep, F.lds, F.tid); }
                    u = NR1 + 2 * (u - NR1);
                    u32x4 st[10]; f32x4 rc[4];
#pragma unroll
                    for (int i = 0; i < 10; ++i) st[i] = (u32x4){0u, 0u, 0u, 0u};
#pragma unroll
                    for (int i = 0; i < 4; ++i) rc[i] = (f32x4){0.f, 0.f, 0.f, 0.f};
                    if (u < UEND) attn_load(F.tid, u - NR1, Pb, ropeA, st, rc);
                    while (u < UEND) {
                        int tl = F.tid; asm volatile("" : "+v"(tl));
                        const bool first = ((u - NR1) & 1) == 0;
                        if (tl == 0 && !first) *bc = NR1 + 2 * (atomicAdd(ctr + rep, 1u) - NR1);
                        attn_stage(F.lds, tl, st);
                        __syncthreads();
                        const int un = first ? u + 1 : (int)*bc;
                        attn_rotary(F.lds, tl, rc);
                        if (un < UEND) attn_load(tl, un - NR1, Pb, ropeA, st, rc);
                        __syncthreads();
                        attn_compute(F.lds, tl & 63, F.wave, u - NR1, Pb, LSE, rep == REP_P2 - 1);
                        __syncthreads();
                        u = un;
                    }
                }
            }
            PH_END;
            if (PH_ON && !DIS_CMB) { RELAUNDER;
                unsigned* ctr = ctl + 16 * (4 + l * 2 + rd); const float* Lbuf = A.out;
                for (int rep = 0; rep < REP_P3; ++rep) {
                for (;;) { const int u = queue_next(ctr + rep, F.lds, F.tid); if (u >= 16 * NSEG + MG / 32) break;
                    if (u < 16 * NSEG) ret_unit(F, (u & 15) >> 2, u & 3, NSEG - 1 - (u >> 4), Pb, RET, Lbuf, ropeR);
                    else { const int cu = u - 16 * NSEG; combine_rows(F, cu * 32, cu * 32 + 32, Pb, LSE, COMB); } } } }
            PH_END;
            if (PH_ON && !DIS_GY) {
                RELAUNDER;
                for (int rep = 0; rep < REP_GY; ++rep) {
                { pg8::Gemm g{COMB, (const bf16*)(wl + W_A), MG, DM, 512}; pg8::StaticOrder S; S.init(MG, DM, F.G, bx); pg8::EpiGateA E{Gb, SCR};
                  pg8::gemm_phase<pg8::EpiGateA, pg8::StaticOrder, true, true>(F.lds, g, S, E); }
                __syncthreads();
                { pg8::Gemm g{RET, (const bf16*)(wl + W_B), MG, DM, DM}; pg8::StaticOrder S; S.init(MG, DM, F.G, bx); pg8::EpiGateB E{Gb, SCR, MRG};
                  pg8::gemm_phase<pg8::EpiGateB, pg8::StaticOrder, true, true>(F.lds, g, S, E); }
                __syncthreads(); }
            }
            PH_END;
            if (PH_ON && !DIS_GO) {
                RELAUNDER;
                pg8::Gemm g{MRG, (const bf16*)(wl + W_O), MG, DM, DM}; pg8::StaticOrder S; S.init(MG, DM, F.G, bx);
                pg8::EpiResid E{XN + roff * DM, PART + roff * 16};
                pg8::gemm_phase<pg8::EpiResid, pg8::StaticOrder, true, true>(F.lds, g, S, E);
            }
            PH_END;
        }
        if (PH_ON && !DIS_UP) {
            RELAUNDER;
            pg8::Gemm g{XN, (const bf16*)(wl + W_UP), M, DFF, DM}; pg8::StaticOrder S; S.init(M, DFF, F.G, bx); pg8::EpiUp E{Hb, PART};
            for (int rep = 0; rep < REP_UP; ++rep) { pg8::gemm_phase<pg8::EpiUp, pg8::StaticOrder, true, true>(F.lds, g, S, E); __syncthreads(); }
        }
        PH_END;
        if (PH_ON && !DIS_DN) {
            RELAUNDER;
            pg8::Gemm g{Hb, (const bf16*)(wl + W_DN), M, DM, DFF}; pg8::StaticOrder S; S.init(M, DM, F.G, bx); pg8::EpiResid E{XN, PART};
            pg8::gemm_phase<pg8::EpiResid, pg8::StaticOrder, true, true>(F.lds, g, S, E);
        }
        PH_END;
    }
    if (PH_ON && !DIS_FIN) {
        const int gw = blockIdx.x * NWAVES + F.wave, NGW = F.G * NWAVES;
        for (int m = gw; m < M; m += NGW) { const float rs = pg8::row_rstd(PART, m); f32x4* xr = (f32x4*)(A.out + (size_t)m * DM) + F.lane; const f32x4* gr = (const f32x4*)A.final_norm + F.lane;
            const u32x2* xb = (const u32x2*)(XN + (size_t)m * DM) + F.lane;
#pragma unroll
            for (int j = 0; j < 4; ++j) { const u32x2 b = xb[64 * j]; const f32x4 v = (f32x4){bflo(b.x), bfhi(b.x), bflo(b.y), bfhi(b.y)}, gg = gr[64 * j]; xr[64 * j] = v * rs * gg; } }
    }
#undef PH_ON
#undef PH_END
}

#ifndef N_LAUNCH_MODE
#define N_LAUNCH_MODE 0
#endif
extern "C" void kernel_launch(void* const* d_in, const int* in_sizes, int n_in, void* d_out, int out_size, void* d_ws, size_t ws_size, hipStream_t stream) {
    static int grid = 0;
    if (grid == 0) {
        if (n_in != 10 || in_sizes[0] != M * DM || out_size != M * DM || ws_size < WS_END) { fprintf(stderr, "kernel_launch: unexpected shapes / workspace (n_in %d, in0 %d, out %d, ws %zu)\n", n_in, n_in > 0 ? in_sizes[0] : -1, out_size, ws_size); grid = -1; return; }
        int dev = 0, cus = 0, per_cu = 0;
        hipGetDevice(&dev); hipDeviceGetAttribute(&cus, hipDeviceAttributeMultiprocessorCount, dev);
        if (hipFuncSetAttribute((const void*)fwd_kernel, hipFuncAttributeMaxDynamicSharedMemorySize, LDS_BYTES) != hipSuccess) { fprintf(stderr, "kernel_launch: hipFuncSetAttribute failed\n"); grid = -1; return; }
        if (hipOccupancyMaxActiveBlocksPerMultiprocessor(&per_cu, (const void*)fwd_kernel, NTHR, LDS_BYTES) != hipSuccess || per_cu < 1) { fprintf(stderr, "kernel_launch: occupancy query gave %d\n", per_cu); per_cu = 1; }
        (void)hipGetLastError();
        grid = cus * 1;
        fprintf(stderr, "kernel_launch: cus %d per_cu %d grid %d ws %zu\n", cus, per_cu, grid, ws_size);
    }
    if (grid < 0) return;
    (void)hipMemsetAsync((char*)d_ws + WS_CTL, 0, CTL_BYTES, stream);
    Args a{};
    for (int i = 0; i < 10; ++i) a.in[i] = (const float*)d_in[i];
    a.out = (float*)d_out; a.ws = (unsigned char*)d_ws;
#if N_LAUNCH_MODE == 0
    a.ph_lo = 0; a.ph_hi = N_PHASES;
    void* kargs[] = {&a};
    hipError_t e = hipLaunchCooperativeKernel((const void*)fwd_kernel, dim3(grid), dim3(NTHR), kargs, LDS_BYTES, stream);
    if (e != hipSuccess) fprintf(stderr, "kernel_launch: cooperative launch failed: %s (grid %d)\n", hipGetErrorString(e), grid);
#else
    for (int p = 0; p < N_PHASES; ++p) { a.ph_lo = p; a.ph_hi = p + 1; hipLaunchKernelGGL(fwd_kernel, dim3(grid), dim3(NTHR), LDS_BYTES, stream, a); }
#endif
}
```

```cpp
#include <hip/hip_runtime.h>
#include <hip/hip_cooperative_groups.h>
#include <cstdio>
#include <cstdint>
namespace cg = cooperative_groups;
namespace pg8 {
#define PG8_LAS __attribute__((address_space(3)))
typedef unsigned short bf16_t;
typedef short bf16x8 __attribute__((ext_vector_type(8)));
typedef _Float16 f16x8 __attribute__((ext_vector_type(8)));
typedef float f32x4 __attribute__((ext_vector_type(4)));
typedef unsigned u32x4 __attribute__((ext_vector_type(4)));
constexpr int BM = 256, BK = 64, HALF = 128, HTB = HALF * BK * 2  , STAGE_BYTES = 8 * HTB, NXCD = 8, WGM = 8;

__host__ __device__ __forceinline__ int lds_byte(int r, int c) { const int st = (r >> 4) * 2 + (c >> 5), rr = r & 15, cc = c & 31, ob = rr * 64 + cc * 2; return st * 1024 + (ob ^ (((ob >> 9) & 1) << 5)); }
__host__ __device__ __forceinline__ void stage_rc(int b, int& R, int& C) { const int st = b / 1024, sb = b % 1024, swz = sb ^ (((sb >> 9) & 1) << 5); R = (st >> 1) * 16 + swz / 64; C = (st & 1) * 32 + (swz % 64) / 2; }
__host__ __device__ __forceinline__ int perm32(int rho) { const int n = rho >> 4, i = rho & 15; return 8 * (i >> 2) + 4 * n + (i & 3); }

struct Unit { int pm, pn; };
struct Gemm { const bf16_t* A; const bf16_t* Bt; int M, N, K; };

struct StaticOrder {
    int nM, nN, nwg, G, c;
    __host__ __device__ void init(int M, int N, int G_, int c_) { nM = M / BM; nN = N / BM; nwg = nM * nN; G = G_; c = c_; }
    __host__ __device__ bool next(int i, Unit& u) const {
        const long L = (long)i * G + c; if (L >= nwg) return false;
        int wgid = (int)L; { const int q = nwg / NXCD, r = nwg % NXCD, xcd = wgid % NXCD, off = wgid / NXCD; wgid = (xcd < r ? xcd * (q + 1) : r * (q + 1) + (xcd - r) * q) + off; }
        const int nig = WGM * nN, gid = wgid / nig, fm = gid * WGM, gsz = (nM - fm) < WGM ? (nM - fm) : WGM;
        u.pm = fm + ((wgid % nig) % gsz); u.pn = (wgid % nig) / gsz; return true;
    }
    __device__ __forceinline__ void a_ready(const Unit&) const {}
    __device__ __forceinline__ void done(const Unit&) const {}
};

typedef float f32x2_t __attribute__((ext_vector_type(2))); typedef __bf16 bf16x2_t __attribute__((ext_vector_type(2)));
typedef unsigned u32x2 __attribute__((ext_vector_type(2)));
typedef _Float16 f16x2_t __attribute__((ext_vector_type(2)));
__device__ __forceinline__ unsigned cvtpk(float lo, float hi) { f32x2_t v = {lo, hi}; f16x2_t b = __builtin_convertvector(v, f16x2_t); return __builtin_bit_cast(unsigned, b); }
__device__ __forceinline__ float bflo(unsigned w) { const f16x2_t b = __builtin_bit_cast(f16x2_t, w); return (float)b[0]; }
__device__ __forceinline__ float bfhi(unsigned w) { const f16x2_t b = __builtin_bit_cast(f16x2_t, w); return (float)b[1]; }
__device__ __forceinline__ float sigmoidf_(float x) { return __builtin_amdgcn_rcpf(1.0f + __builtin_amdgcn_exp2f(-1.4426950408889634f * x)); }
__device__ __forceinline__ float row_rstd(const float* part, int row) {
    const f32x4* p = (const f32x4*)(part + (size_t)row * 16);
    const f32x4 a = p[0], b = p[1], c = p[2], d = p[3];
    const float s = (((a[0] + a[1]) + (a[2] + a[3])) + ((b[0] + b[1]) + (b[2] + b[3]))) + (((c[0] + c[1]) + (c[2] + c[3])) + ((d[0] + d[1]) + (d[2] + d[3])));
    return 1.0f / sqrtf(s * (1.0f / 1024.0f) + 1e-6f);
}
__device__ __forceinline__ void rows_rstd(const float* part, int row0, int fq, float (&rs)[2][4]) {
    f32x4 pv[2][4];
#pragma unroll
    for (int ai = 0; ai < 2; ++ai)
#pragma unroll
        for (int m = 0; m < 4; ++m) pv[ai][m] = *(const f32x4*)(part + (size_t)(row0 + ai * HALF + m * 16) * 16 + 4 * fq);
#pragma unroll
    for (int ai = 0; ai < 2; ++ai)
#pragma unroll
        for (int m = 0; m < 4; ++m) { float s = (pv[ai][m][0] + pv[ai][m][1]) + (pv[ai][m][2] + pv[ai][m][3]); s += __shfl_xor(s, 16); s += __shfl_xor(s, 32); rs[ai][m] = 1.0f / sqrtf(s * (1.0f / 1024.0f) + 1e-6f); }
}
constexpr size_t PL_A = 0, PL_QR = (size_t)4 * 3 * 24 * 4096 * 64, PL_QK_SZ = (size_t)4 * 4 * 4096 * 128, PL_VR = PL_QR + 2 * PL_QK_SZ, PL_VG_SZ = (size_t)4 * 4 * 4096 * 256;
struct EpiProj {
    static constexpr bool PERM = true, AFTER_DRAIN = false;
    bf16_t* P; bf16_t* G; const PG8_LAS float* rsl;
    __device__ __forceinline__ void operator()(const f32x4 (&acc)[2][2][4][2], const Unit& u, int wr, int wc, int fr, int fq) const {
        const int row0 = u.pm * BM + wr * 64 + fr; const int pn = u.pn;
        float rs[2][4];
#pragma unroll
        for (int ai = 0; ai < 2; ++ai)
#pragma unroll
            for (int m = 0; m < 4; ++m) rs[ai][m] = rsl[ai * HALF + wr * 64 + m * 16 + fr];
#pragma unroll
        for (int ai = 0; ai < 2; ++ai)
#pragma unroll
            for (int m = 0; m < 4; ++m) { const int row = row0 + ai * HALF + m * 16; const int bl = row >> 12, t = row & 4095;
#pragma unroll
                for (int bj = 0; bj < 2; ++bj) { const f32x4 v0 = acc[ai][bj][m][0] * rs[ai][m], v1 = acc[ai][bj][m][1] * rs[ai][m];
                    u32x4 w; w.x = cvtpk(v0[0], v0[1]); w.y = cvtpk(v0[2], v0[3]); w.z = cvtpk(v1[0], v1[1]); w.w = cvtpk(v1[2], v1[3]);
                    const int ct = bj * HALF + wc * 32 + 8 * fq;
                    bf16_t* dst;
                    if (pn < 18) { const int sect = pn / 6, hh = (pn - sect * 6) * 4 + (ct >> 6), dsh = 2 * (hh >> 3); const int idx = ((t & ((1 << dsh) - 1)) << (12 - dsh)) + (t >> dsh);
                        dst = P + PL_A + ((size_t)((bl * 3 + sect) * 24 + hh) * 4096 + idx) * 64 + (ct & 63); }
                    else if (pn < 22) { const int qk = (pn - 18) >> 1, head = ((pn - 18) & 1) * 2 + (ct >> 7);
                        dst = P + PL_QR + (size_t)qk * PL_QK_SZ + ((size_t)(bl * 4 + head) * 4096 + t) * 128 + (ct & 127); }
                    else if (pn < 30) { const int vg = (pn - 22) >> 2, head = (pn - 22) & 3;
                        dst = P + PL_VR + (size_t)vg * PL_VG_SZ + ((size_t)(bl * 4 + head) * 4096 + t) * 256 + ct; }
                    else dst = G + (size_t)row * 2048 + (pn - 30) * 256 + ct;
                    *(u32x4*)dst = w; } }
    }
};
struct EpiGateA {
    static constexpr bool PERM = true, AFTER_DRAIN = false;
    const bf16_t* G; bf16_t* scr;
    __device__ __forceinline__ void operator()(const f32x4 (&acc)[2][2][4][2], const Unit& u, int wr, int wc, int fr, int fq) const {
        const int row0 = u.pm * BM + wr * 64 + fr, col0 = u.pn * BM + wc * 32 + 8 * fq;
#pragma unroll
        for (int ai = 0; ai < 2; ++ai) { u32x4 gv[4][2];
#pragma unroll
            for (int m = 0; m < 4; ++m)
#pragma unroll
                for (int bj = 0; bj < 2; ++bj) gv[m][bj] = *(const u32x4*)(G + (size_t)(row0 + ai * HALF + m * 16) * 2048 + col0 + bj * HALF);
#pragma unroll
            for (int m = 0; m < 4; ++m) { const int row = row0 + ai * HALF + m * 16;
#pragma unroll
                for (int bj = 0; bj < 2; ++bj) { const int col = col0 + bj * HALF; const u32x4 g = gv[m][bj];
                    f32x4 v0 = acc[ai][bj][m][0], v1 = acc[ai][bj][m][1];
                    v0[0] *= sigmoidf_(bflo(g.x)); v0[1] *= sigmoidf_(bfhi(g.x)); v0[2] *= sigmoidf_(bflo(g.y)); v0[3] *= sigmoidf_(bfhi(g.y));
                    v1[0] *= sigmoidf_(bflo(g.z)); v1[1] *= sigmoidf_(bfhi(g.z)); v1[2] *= sigmoidf_(bflo(g.w)); v1[3] *= sigmoidf_(bfhi(g.w));
                    u32x4 w; w.x = cvtpk(v0[0], v0[1]); w.y = cvtpk(v0[2], v0[3]); w.z = cvtpk(v1[0], v1[1]); w.w = cvtpk(v1[2], v1[3]);
                    *(u32x4*)(scr + (size_t)row * 1024 + col) = w; } }
            asm volatile("" ::: "memory"); }
    }
};
struct EpiGateB {
    static constexpr bool PERM = true, AFTER_DRAIN = false;
    const bf16_t* G; const bf16_t* scr; bf16_t* mrg;
    __device__ __forceinline__ void operator()(const f32x4 (&acc)[2][2][4][2], const Unit& u, int wr, int wc, int fr, int fq) const {
        const int row0 = u.pm * BM + wr * 64 + fr, col0 = u.pn * BM + wc * 32 + 8 * fq;
#pragma unroll
        for (int ai = 0; ai < 2; ++ai)
#pragma unroll
            for (int mh = 0; mh < 2; ++mh) { u32x4 gv[2][2]; u32x4 sv[2][2];
#pragma unroll
                for (int mm = 0; mm < 2; ++mm)
#pragma unroll
                    for (int bj = 0; bj < 2; ++bj) { const int row = row0 + ai * HALF + (2 * mh + mm) * 16, col = col0 + bj * HALF;
                        gv[mm][bj] = *(const u32x4*)(G + (size_t)row * 2048 + 1024 + col); sv[mm][bj] = *(const u32x4*)(scr + (size_t)row * 1024 + col); }
#pragma unroll
                for (int mm = 0; mm < 2; ++mm)
#pragma unroll
                    for (int bj = 0; bj < 2; ++bj) { const int m = 2 * mh + mm; const int row = row0 + ai * HALF + m * 16, col = col0 + bj * HALF; const u32x4 g = gv[mm][bj]; const u32x4 sw = sv[mm][bj]; const f32x4 s0 = (f32x4){bflo(sw.x), bfhi(sw.x), bflo(sw.y), bfhi(sw.y)}, s1 = (f32x4){bflo(sw.z), bfhi(sw.z), bflo(sw.w), bfhi(sw.w)};
                        f32x4 v0 = acc[ai][bj][m][0], v1 = acc[ai][bj][m][1];
                        v0[0] = s0[0] + v0[0] * sigmoidf_(bflo(g.x)); v0[1] = s0[1] + v0[1] * sigmoidf_(bfhi(g.x)); v0[2] = s0[2] + v0[2] * sigmoidf_(bflo(g.y)); v0[3] = s0[3] + v0[3] * sigmoidf_(bfhi(g.y));
                        v1[0] = s1[0] + v1[0] * sigmoidf_(bflo(g.z)); v1[1] = s1[1] + v1[1] * sigmoidf_(bfhi(g.z)); v1[2] = s1[2] + v1[2] * sigmoidf_(bflo(g.w)); v1[3] = s1[3] + v1[3] * sigmoidf_(bfhi(g.w));
                        u32x4 w; w.x = cvtpk(v0[0], v0[1]); w.y = cvtpk(v0[2], v0[3]); w.z = cvtpk(v1[0], v1[1]); w.w = cvtpk(v1[2], v1[3]);
                        *(u32x4*)(mrg + (size_t)row * 1024 + col) = w; }
                asm volatile("" ::: "memory"); }
    }
};
struct EpiResid {
    static constexpr bool PERM = false, AFTER_DRAIN = false;
    bf16_t* xres; float* part;
    __device__ __forceinline__ void operator()(const f32x4 (&acc)[2][2][4][2], const Unit& u, int wr, int wc, int fr, int fq) const {
        const int row0 = u.pm * BM + wr * 64 + fr, col0 = u.pn * BM + wc * 32 + 4 * fq;
#pragma unroll
        for (int ai = 0; ai < 2; ++ai) { u32x2 bs[4][2][2];
#pragma unroll
            for (int m = 0; m < 4; ++m)
#pragma unroll
                for (int bj = 0; bj < 2; ++bj)
#pragma unroll
                    for (int n = 0; n < 2; ++n) bs[m][bj][n] = *(const u32x2*)(xres + (size_t)(row0 + ai * HALF + m * 16) * 1024 + col0 + bj * HALF + n * 16);
#pragma unroll
            for (int m = 0; m < 4; ++m) { const int row = row0 + ai * HALF + m * 16; const size_t off = (size_t)row * 1024 + col0; float ss = 0.f;
#pragma unroll
                for (int bj = 0; bj < 2; ++bj)
#pragma unroll
                    for (int n = 0; n < 2; ++n) { const size_t o2 = off + bj * HALF + n * 16; const u32x2 b = bs[m][bj][n];
                        const f32x4 o = (f32x4){bflo(b.x), bfhi(b.x), bflo(b.y), bfhi(b.y)} + acc[ai][bj][m][n];
                        ss += (o[0] * o[0] + o[1] * o[1]) + (o[2] * o[2] + o[3] * o[3]);
                        u32x2 w; w.x = cvtpk(o[0], o[1]); w.y = cvtpk(o[2], o[3]); *(u32x2*)(xres + o2) = w; }
                ss += __shfl_xor(ss, 16); ss += __shfl_xor(ss, 32);
                if (fq == 0) part[(size_t)row * 16 + u.pn * 4 + wc] = ss; }
            asm volatile("" ::: "memory"); }
    }
};
struct EpiUp {
    static constexpr bool PERM = true, AFTER_DRAIN = false;
    bf16_t* H; const PG8_LAS float* rsl; int pmA;
    __device__ __forceinline__ void operator()(const f32x4 (&acc)[2][2][4][2], const Unit& u, int wr, int wc, int fr, int fq) const {
        const int row0 = u.pm * BM + wr * 64 + fr, col0 = u.pn * BM + wc * 32 + 8 * fq;
        float rs[2][4]; const PG8_LAS float* tb = rsl + (u.pm == pmA ? 0 : 256);
#pragma unroll
        for (int ai = 0; ai < 2; ++ai)
#pragma unroll
            for (int m = 0; m < 4; ++m) rs[ai][m] = tb[ai * HALF + wr * 64 + m * 16 + fr];
#pragma unroll
        for (int ai = 0; ai < 2; ++ai)
#pragma unroll
            for (int m = 0; m < 4; ++m) { const int row = row0 + ai * HALF + m * 16; bf16_t* rowp = H + (size_t)row * 4096 + col0;
#pragma unroll
                for (int bj = 0; bj < 2; ++bj) { f32x4 v0 = acc[ai][bj][m][0] * rs[ai][m], v1 = acc[ai][bj][m][1] * rs[ai][m];
#pragma unroll
                    for (int e = 0; e < 4; ++e) { const float a = fmaxf(v0[e], 0.f), b = fmaxf(v1[e], 0.f); v0[e] = a * a; v1[e] = b * b; }
                    u32x4 w; w.x = cvtpk(v0[0], v0[1]); w.y = cvtpk(v0[2], v0[3]); w.z = cvtpk(v1[0], v1[1]); w.w = cvtpk(v1[2], v1[3]);
                    *(u32x4*)(rowp + bj * HALF) = w; } }
    }
};

template <class Epi, class Sched, bool ALIGN_EPI = false, bool SP2 = false>
__device__ __forceinline__ void gemm_phase(PG8_LAS unsigned char* lds, const Gemm g, const Sched& S, const Epi& E) {
    int tid_l = threadIdx.x; asm volatile("" : "+v"(tid_l));
    const int tid = tid_l, wid = __builtin_amdgcn_readfirstlane(tid >> 6), lane = tid & 63, wr = wid >> 2, wc = wid & 3, fr = lane & 15, fq = lane >> 4;
    const int K = g.K, nt = K / BK;
    unsigned voffA[2], voffB[2];
#pragma unroll
    for (int i = 0; i < 2; ++i) { int R, C; stage_rc(tid * 16 + i * 8192, R, C); const int Rb = Epi::PERM ? ((R & ~31) + perm32(R & 31)) : R;
        voffA[i] = (unsigned)(R * K + C) * 2u; voffB[i] = (unsigned)(Rb * K + C) * 2u; }
    const size_t kstep = (size_t)(BK * 2);
    const size_t hstep = (size_t)HALF * K * 2;
    const size_t tstep = 2 * hstep;
    const unsigned ldsw = (unsigned)wid * 1024u;
    const int aoff = lds_byte(wr * 64 + fr, fq * 8), boff = lds_byte(wc * 32 + fr, fq * 8);
#define PG8_SA(b, h) (((b) * 2 + (h)) * HTB)
#define PG8_SB(b, h) ((4 + (b) * 2 + (h)) * HTB)
#define PG8_STAGE(bufoff, gbase, voff) do { _Pragma("unroll") for (int _i = 0; _i < 2; ++_i) \
        __builtin_amdgcn_global_load_lds((const unsigned*)((const char*)(gbase) + (voff)[_i]), (PG8_LAS unsigned*)(lds + (bufoff) + ldsw + _i * 8192), 16, 0, 0); } while (0)
#define PG8_LDA(dst, b, h) do { _Pragma("unroll") for (int m = 0; m < 4; ++m) _Pragma("unroll") for (int k = 0; k < 2; ++k) dst[m][k] = *(const PG8_LAS bf16x8*)(lds + PG8_SA(b, h) + aoff + m * 2048 + k * 1024); } while (0)
#define PG8_LDB(dst, b, h) do { _Pragma("unroll") for (int n = 0; n < 2; ++n) _Pragma("unroll") for (int k = 0; k < 2; ++k) dst[n][k] = *(const PG8_LAS bf16x8*)(lds + PG8_SB(b, h) + boff + n * 2048 + k * 1024); } while (0)
#define PG8_MMA(ai, bj, At, Bt) do { __builtin_amdgcn_s_setprio(1); _Pragma("unroll") for (int m = 0; m < 4; ++m) _Pragma("unroll") for (int n = 0; n < 2; ++n) _Pragma("unroll") for (int k = 0; k < 2; ++k) \
        acc[ai][bj][m][n] = __builtin_amdgcn_mfma_f32_16x16x32_f16(__builtin_bit_cast(f16x8, Bt[n][k]), __builtin_bit_cast(f16x8, At[m][k]), acc[ai][bj][m][n], 0, 0, 0); __builtin_amdgcn_s_setprio(0); } while (0)
#define PG8_WAIT_V(n) asm volatile("s_waitcnt vmcnt(" #n ")" ::: "memory")
#define PG8_WAIT_L(n) asm volatile("s_waitcnt lgkmcnt(" #n ")" ::: "memory")
#define PG8_BAR __builtin_amdgcn_s_barrier()
#define PG8_SCHED __builtin_amdgcn_sched_barrier(0)
    Unit cur, nxt; int ui = 0;
    if (!S.next(0, cur)) return;
    f32x4 acc[2][2][4][2];
#pragma unroll
    for (int a = 0; a < 2; ++a)
#pragma unroll
        for (int b = 0; b < 2; ++b)
#pragma unroll
            for (int m = 0; m < 4; ++m)
#pragma unroll
                for (int n = 0; n < 2; ++n) acc[a][b][m][n] = (f32x4){0.f, 0.f, 0.f, 0.f};
    bf16x8 At[4][2], B0[2][2], B1[2][2];
    const char* cA = (const char*)g.A + (size_t)cur.pm * tstep; const char* cB = (const char*)g.Bt + (size_t)cur.pn * tstep;
    S.a_ready(cur);
    if constexpr (SP2) {
        PG8_STAGE(PG8_SB(0, 0), cB, voffB); PG8_STAGE(PG8_SB(0, 1), cB + hstep, voffB); PG8_STAGE(PG8_SA(0, 0), cA, voffA); PG8_STAGE(PG8_SA(0, 1), cA + hstep, voffA);
        if (wr == 1) PG8_BAR;
        PG8_WAIT_V(2); PG8_BAR;
        PG8_STAGE(PG8_SB(1, 0), cB + kstep, voffB); PG8_STAGE(PG8_SA(1, 0), cA + kstep, voffA); PG8_STAGE(PG8_SB(1, 1), cB + hstep + kstep, voffB);
        PG8_WAIT_V(6); PG8_BAR;
    } else {
        PG8_STAGE(PG8_SB(0, 0), cB, voffB); PG8_STAGE(PG8_SA(0, 0), cA, voffA); PG8_STAGE(PG8_SB(0, 1), cB + hstep, voffB); PG8_STAGE(PG8_SA(0, 1), cA + hstep, voffA);
        if (wr == 1) PG8_BAR;
        PG8_WAIT_V(4); PG8_BAR;
        PG8_STAGE(PG8_SB(1, 0), cB + kstep, voffB); PG8_STAGE(PG8_SA(1, 0), cA + kstep, voffA); PG8_STAGE(PG8_SB(1, 1), cB + hstep + kstep, voffB);
        PG8_WAIT_V(6); PG8_BAR;
    }
    for (;;) {
        const bool has_next = S.next(ui + 1, nxt);
        const char* nA = has_next ? (const char*)g.A + (size_t)nxt.pm * tstep : cA; const char* nB = has_next ? (const char*)g.Bt + (size_t)nxt.pn * tstep : cB;
        for (int t = 0; t < nt; t += 2) {
            const bool last = (t == nt - 2);
            const char* a1 = cA + (size_t)(t + 1) * kstep;
            const char* a2 = last ? nA : cA + (size_t)(t + 2) * kstep; const char* b2 = last ? nB : cB + (size_t)(t + 2) * kstep;
            const char* a3 = a2 + kstep; const char* b3 = b2 + kstep;
            if (last && has_next) S.a_ready(nxt);
            if constexpr (SP2) {
            PG8_LDB(B0, 0, 0); PG8_LDB(B1, 0, 1); PG8_SCHED; PG8_LDA(At, 0, 0); PG8_STAGE(PG8_SA(1, 1), a1 + hstep, voffA);
            PG8_WAIT_V(8); PG8_WAIT_L(0); PG8_BAR; PG8_MMA(0, 0, At, B0); PG8_MMA(0, 1, At, B1); PG8_BAR; PG8_SCHED;
            PG8_LDA(At, 0, 1); PG8_STAGE(PG8_SB(0, 0), b2, voffB); PG8_STAGE(PG8_SB(0, 1), b2 + hstep, voffB); PG8_STAGE(PG8_SA(0, 0), a2, voffA);
            PG8_WAIT_V(8); PG8_WAIT_L(0); PG8_BAR; PG8_MMA(1, 0, At, B0); PG8_MMA(1, 1, At, B1); PG8_BAR; PG8_SCHED;
            PG8_LDB(B0, 1, 0); PG8_LDB(B1, 1, 1); PG8_SCHED; PG8_LDA(At, 1, 0); PG8_STAGE(PG8_SA(0, 1), a2 + hstep, voffA);
            PG8_WAIT_V(8); PG8_WAIT_L(0); PG8_BAR; PG8_MMA(0, 0, At, B0); PG8_MMA(0, 1, At, B1); PG8_BAR; PG8_SCHED;
            PG8_LDA(At, 1, 1); PG8_STAGE(PG8_SB(1, 0), b3, voffB); PG8_STAGE(PG8_SB(1, 1), b3 + hstep, voffB); PG8_STAGE(PG8_SA(1, 0), a3, voffA);
            PG8_WAIT_V(8); PG8_WAIT_L(0); PG8_BAR; PG8_MMA(1, 0, At, B0); PG8_MMA(1, 1, At, B1); PG8_BAR; PG8_SCHED;
            } else {
            PG8_LDB(B0, 0, 0); PG8_SCHED; PG8_LDA(At, 0, 0); PG8_STAGE(PG8_SA(1, 1), a1 + hstep, voffA);
            PG8_WAIT_L(8); PG8_BAR; PG8_WAIT_L(0); PG8_MMA(0, 0, At, B0); PG8_BAR; PG8_SCHED;
            PG8_LDB(B1, 0, 1); PG8_STAGE(PG8_SB(0, 0), b2, voffB);
            PG8_BAR; PG8_WAIT_L(0); PG8_MMA(0, 1, At, B1); PG8_BAR;
            PG8_LDA(At, 0, 1); PG8_STAGE(PG8_SA(0, 0), a2, voffA);
            PG8_BAR; PG8_WAIT_L(0); PG8_MMA(1, 0, At, B0); PG8_BAR; PG8_SCHED;
            PG8_STAGE(PG8_SB(0, 1), b2 + hstep, voffB);
            PG8_WAIT_V(6); PG8_BAR; PG8_MMA(1, 1, At, B1); PG8_BAR;
            PG8_LDB(B0, 1, 0); PG8_SCHED; PG8_LDA(At, 1, 0); PG8_STAGE(PG8_SA(0, 1), a2 + hstep, voffA);
            PG8_WAIT_L(8); PG8_BAR; PG8_WAIT_L(0); PG8_MMA(0, 0, At, B0); PG8_BAR; PG8_SCHED;
            PG8_LDB(B1, 1, 1); PG8_STAGE(PG8_SB(1, 0), b3, voffB);
            PG8_BAR; PG8_WAIT_L(0); PG8_MMA(0, 1, At, B1); PG8_BAR;
            PG8_LDA(At, 1, 1); PG8_STAGE(PG8_SA(1, 0), a3, voffA);
            PG8_BAR; PG8_WAIT_L(0); PG8_MMA(1, 0, At, B0); PG8_BAR; PG8_SCHED;
            PG8_STAGE(PG8_SB(1, 1), b3 + hstep, voffB);
            PG8_WAIT_V(6); PG8_BAR; PG8_MMA(1, 1, At, B1); PG8_BAR;
            }
        }
        if constexpr (ALIGN_EPI) { if (wr == 0) PG8_BAR; }
        if constexpr (!Epi::AFTER_DRAIN) { E(acc, cur, wr, wc, fr, fq); S.done(cur); }
        if (!has_next) break;
#pragma unroll
        for (int a = 0; a < 2; ++a)
#pragma unroll
            for (int b = 0; b < 2; ++b)
#pragma unroll
                for (int m = 0; m < 4; ++m)
#pragma unroll
                    for (int n = 0; n < 2; ++n) acc[a][b][m][n] = (f32x4){0.f, 0.f, 0.f, 0.f};
        cur = nxt; cA = nA; cB = nB; ++ui;
        if constexpr (ALIGN_EPI) { if (wr == 1) PG8_BAR; }
    }
    PG8_WAIT_V(0);
    if constexpr (!ALIGN_EPI) { if (wr == 0) PG8_BAR; }
    PG8_BAR;
    if constexpr (Epi::AFTER_DRAIN) { E.fused(acc, cur, wr, wc, fr, fq, lds, wid, lane); S.done(cur); }
#undef PG8_SA
#undef PG8_SB
#undef PG8_STAGE
#undef PG8_LDA
#undef PG8_LDB
#undef PG8_MMA
#undef PG8_WAIT_V
#undef PG8_WAIT_L
#undef PG8_BAR
#undef PG8_SCHED
}
}

#define GAS __attribute__((address_space(1)))
#define LAS __attribute__((address_space(3)))
typedef unsigned short bf16;
typedef unsigned u32x4 __attribute__((ext_vector_type(4)));
typedef unsigned u32x2 __attribute__((ext_vector_type(2)));
typedef float f32x4 __attribute__((ext_vector_type(4)));
typedef float f32x16 __attribute__((ext_vector_type(16)));
typedef short bf16x8 __attribute__((ext_vector_type(8)));
typedef short s16x4 __attribute__((ext_vector_type(4)));
using pg8::cvtpk; using pg8::bflo; using pg8::bfhi; using pg8::sigmoidf_; using pg8::PL_A; using pg8::PL_QR; using pg8::PL_QK_SZ; using pg8::PL_VR; using pg8::PL_VG_SZ;

constexpr int NB = 8, SEQ = 4096, DM = 1024, M = NB * SEQ, MG = M / 2, DIN = 9728, DFF = 4096;
constexpr int PW = 7680, GW = 2048;
constexpr int C_QA = 0, C_KA = 1536, C_VA = 3072, C_QR = 4608, C_KR = 5120, C_VR = 5632, C_GR = 6656;
constexpr int NWAVES = 8, NTHR = 512;
constexpr size_t MiB = 1u << 20;
constexpr size_t WS_CTL = 0, CTL_BYTES = 32768, WS_BAR = 4096;
constexpr size_t WS_ROPEA = 64 * 1024;
constexpr size_t WS_ROPER = 1 * MiB;
constexpr size_t WS_PART = 3 * MiB;
constexpr size_t WS_LSE = 5 * MiB;
constexpr size_t WS_W = 8 * MiB, W_LAYER = 40 * MiB;
constexpr size_t W_IN = 0, W_A = 19 * MiB, W_B = 20 * MiB, W_O = 22 * MiB, W_UP = 24 * MiB, W_DN = 32 * MiB;
constexpr size_t WS_XN = 88 * MiB;
constexpr size_t WS_P = 152 * MiB;
constexpr size_t WS_G = 392 * MiB;
constexpr size_t WS_COMB = 456 * MiB;
constexpr size_t WS_RET = 472 * MiB;
constexpr size_t WS_END = 504 * MiB;
constexpr size_t WS_SCR = 152 * MiB;
constexpr size_t WS_MRG = 216 * MiB;
constexpr size_t WS_H = 152 * MiB;
constexpr int LDS_BYTES = 147456;
constexpr int LDS_BCAST = LDS_BYTES - 64;
constexpr int N_PHASES = 26;

struct Frame { LAS unsigned char* lds; int tid, lane, wave, G; };

__device__ __forceinline__ float wave_sum(float v) {
#pragma unroll
    for (int o = 1; o < 64; o <<= 1) v += __shfl_xor(v, o);
    return v;
}
__device__ __forceinline__ void p0_transpose_item(const float* W, const float* gain, int K, int N, bf16* WT, LAS float* scr, int item, int lane) {
    const int nblk = N / 32, kb = item / nblk, nb = item % nblk, k0 = 64 * kb, n0 = 32 * nb;
    float tv[32];
#pragma unroll
    for (int i = 0; i < 32; ++i) { const int kk = 2 * i + (lane >> 5); tv[i] = W[(size_t)(k0 + kk) * N + n0 + (lane & 31)]; }
    if (gain) {
#pragma unroll
        for (int i = 0; i < 32; ++i) tv[i] *= gain[k0 + 2 * i + (lane >> 5)]; }
#pragma unroll
    for (int i = 0; i < 32; ++i) scr[(2 * i + (lane >> 5)) * 33 + (lane & 31)] = tv[i];
    asm volatile("s_waitcnt lgkmcnt(0)" ::: "memory");
    const int c = lane & 7;
#pragma unroll
    for (int j = 0; j < 4; ++j) { const int n = (lane >> 3) + 8 * j; const LAS float* s = scr + (8 * c) * 33 + n;
        u32x4 o; o.x = cvtpk(s[0 * 33], s[1 * 33]); o.y = cvtpk(s[2 * 33], s[3 * 33]); o.z = cvtpk(s[4 * 33], s[5 * 33]); o.w = cvtpk(s[6 * 33], s[7 * 33]);
        *(u32x4*)(WT + (size_t)(n0 + n) * K + k0 + 8 * c) = o; }
    asm volatile("s_waitcnt lgkmcnt(0)" ::: "memory");
}
__device__ __forceinline__ void sincos_acc(double ang, float& s, float& c) {
    const double q = rint(ang * 0.6366197723675814);
    const double r = (ang - q * 1.5707963267948966) - q * 6.123233995736766e-17;
    const double r2 = r * r;
    const double sp = r * (1.0 + r2 * (-1.0 / 6.0 + r2 * (1.0 / 120.0 + r2 * (-1.0 / 5040.0 + r2 * (1.0 / 362880.0 + r2 * (-1.0 / 39916800.0))))));
    const double cp = 1.0 + r2 * (-0.5 + r2 * (1.0 / 24.0 + r2 * (-1.0 / 720.0 + r2 * (1.0 / 40320.0 + r2 * (-1.0 / 3628800.0 + r2 * (1.0 / 479001600.0))))));
    const int qi = ((int)q) & 3;
    const double ss = (qi == 0) ? sp : (qi == 1) ? cp : (qi == 2) ? -sp : -cp;
    const double cc = (qi == 0) ? cp : (qi == 1) ? -sp : (qi == 2) ? -cp : sp;
    s = (float)ss; c = (float)cc;
}

struct Ptrs {
    const float *x, *mix_norm, *w_in, *w_a, *w_b, *w_o, *ffn_norm, *w_up, *w_down, *final_norm;
    float* out; unsigned char* ws;
};

__device__ __forceinline__ void p0_prologue(const Frame& F, const Ptrs& A) {
    LAS float* scr = (LAS float*)(F.lds + F.wave * 16384);
    const int gw = blockIdx.x * NWAVES + F.wave, NGW = F.G * NWAVES;
    constexpr int I_IN = (DM / 64) * (DIN / 32), I_A = (512 / 64) * (DM / 32), I_B = (DM / 64) * (DM / 32), I_O = I_B, I_UP = (DM / 64) * (DFF / 32), I_DN = (DFF / 64) * (DM / 32);
    constexpr int I_LAYER = I_IN + I_A + I_B + I_O + I_UP + I_DN;
    for (int it = gw; it < 2 * I_LAYER; it += NGW) {
        const int l = it / I_LAYER; int r = it - l * I_LAYER;
        unsigned char* wl = A.ws + WS_W + (size_t)l * W_LAYER;
        if (r < I_IN) { p0_transpose_item(A.w_in + (size_t)l * DM * DIN, A.mix_norm + l * DM, DM, DIN, (bf16*)(wl + W_IN), scr, r, F.lane); continue; } r -= I_IN;
        if (r < I_A) { p0_transpose_item(A.w_a + (size_t)l * 512 * DM, nullptr, 512, DM, (bf16*)(wl + W_A), scr, r, F.lane); continue; } r -= I_A;
        if (r < I_B) { p0_transpose_item(A.w_b + (size_t)l * DM * DM, nullptr, DM, DM, (bf16*)(wl + W_B), scr, r, F.lane); continue; } r -= I_B;
        if (r < I_O) { p0_transpose_item(A.w_o + (size_t)l * DM * DM, nullptr, DM, DM, (bf16*)(wl + W_O), scr, r, F.lane); continue; } r -= I_O;
        if (r < I_UP) { p0_transpose_item(A.w_up + (size_t)l * DM * DFF, A.ffn_norm + l * DM, DM, DFF, (bf16*)(wl + W_UP), scr, r, F.lane); continue; } r -= I_UP;
        p0_transpose_item(A.w_down + (size_t)l * DFF * DM, nullptr, DFF, DM, (bf16*)(wl + W_DN), scr, r, F.lane);
    }
    bf16* XN = (bf16*)(A.ws + WS_XN); float* PART = (float*)(A.ws + WS_PART);
    for (int m0 = 4 * gw; m0 < M; m0 += 4 * NGW) {
        f32x4 v[4][4];
#pragma unroll
        for (int q = 0; q < 4; ++q)
#pragma unroll
            for (int j = 0; j < 4; ++j) v[q][j] = ((const f32x4*)(A.x + (size_t)(m0 + q) * DM) + F.lane)[64 * j];
#pragma unroll
        for (int q = 0; q < 4; ++q) { float s = 0.f; u32x2* o8 = (u32x2*)(XN + (size_t)(m0 + q) * DM) + F.lane;
#pragma unroll
            for (int j = 0; j < 4; ++j) { const f32x4 t = v[q][j]; s += (t[0] * t[0] + t[1] * t[1]) + (t[2] * t[2] + t[3] * t[3]); u32x2 w; w.x = cvtpk(t[0], t[1]); w.y = cvtpk(t[2], t[3]); o8[64 * j] = w; }
            s = wave_sum(s);
            if (F.lane < 16) PART[(size_t)(m0 + q) * 16 + F.lane] = (F.lane == 0) ? s : 0.f; }
    }
    float* ropeA = (float*)(A.ws + WS_ROPEA); float* ropeR = (float*)(A.ws + WS_ROPER);
    const int gt = blockIdx.x * NTHR + F.tid, NGT = F.G * NTHR;
    for (int i = gt; i < SEQ * 8; i += NGT) { const int pos = i >> 3, j = i & 7; const float inv = 1.0f / powf(500000.0f, (float)j / 8.0f); const float ang = (float)pos * inv; float s, c; sincos_acc((double)ang, s, c); ropeA[i] = c; ropeA[SEQ * 8 + i] = s; }
    for (int i = gt; i < SEQ * 64; i += NGT) { const int pos = i >> 6, j = i & 63; const float inv = 1.0f / powf(10000.0f, (float)j / 64.0f); const float ang = (float)pos * inv; float s, c; sincos_acc((double)ang, s, c); ((unsigned*)ropeR)[i] = cvtpk(c, s); }
}

__device__ __forceinline__ int queue_next(unsigned* ctr, LAS unsigned char* lds, int tid) {
    __syncthreads();
    if (tid == 0) *(volatile LAS unsigned*)(lds + LDS_BCAST) = atomicAdd(ctr, 1u);
    __syncthreads();
    return (int)*(volatile LAS unsigned*)(lds + LDS_BCAST);
}

#define MFMA16(a, b, c) __builtin_amdgcn_mfma_f32_16x16x32_f16(__builtin_bit_cast(pg8::f16x8, (a)), __builtin_bit_cast(pg8::f16x8, (b)), (c), 0, 0, 0)
#define MFMA32(a, b, c) __builtin_amdgcn_mfma_f32_32x32x16_f16(__builtin_bit_cast(pg8::f16x8, (a)), __builtin_bit_cast(pg8::f16x8, (b)), (c), 0, 0, 0)
typedef short v4i16_t __attribute__((ext_vector_type(4)));
__device__ __forceinline__ s16x4 trr(LAS unsigned char* p) { return __builtin_bit_cast(s16x4, __builtin_amdgcn_ds_read_tr16_b64_v4i16((LAS v4i16_t*)p)); }
__device__ __forceinline__ bf16x8 cat8(s16x4 lo, s16x4 hi) { return __builtin_shufflevector(lo, hi, 0, 1, 2, 3, 4, 5, 6, 7); }

constexpr int AT_P = 144;
constexpr int AT_Q = 0, AT_K = 128 * AT_P, AT_V = AT_K + 256 * AT_P;
struct AttnU { int bl, g, h, r, n, dsh; };
__device__ __forceinline__ AttnU attn_decode(int u) {
    AttnU a; a.bl = u / 768; const int rem = u - a.bl * 768; const int gh = rem >> 5, rb = rem & 31; a.g = gh >> 3; a.h = gh & 7;
    a.dsh = 2 * a.g; const int nbs = 5 - a.dsh; a.r = rb >> nbs; a.n = rb & ((1 << nbs) - 1); return a;
}
__device__ __forceinline__ void attn_load(int tid, int u, const bf16* P, const float* ropeA, u32x4 (&st)[10], f32x4 (&rc)[4]) {
    const AttnU a = attn_decode(u); const int rstart = a.r << (12 - a.dsh);
#pragma unroll
    for (int it = 0; it < 10; ++it) { const int idx = it * 512 + tid, row = idx >> 3, ch = idx & 7;
        const int sect = it < 2 ? 0 : (it < 6 ? 1 : 2); const int li = row - (sect == 0 ? 0 : (sect == 1 ? 128 : 384));
        const int sub = (sect == 0 ? a.n * 128 : (a.n - 1) * 128) + li;
        u32x4 v = (u32x4){0u, 0u, 0u, 0u};
        if (sub >= 0) v = *(const u32x4*)(P + PL_A + ((size_t)((a.bl * 3 + sect) * 24 + a.g * 8 + a.h) * 4096 + rstart + sub) * 64 + ch * 8);
        st[it] = v; }
    rc[0] = rc[1] = rc[2] = rc[3] = (f32x4){0.f, 0.f, 0.f, 0.f};
    if (tid < 384) { const int sub = (tid < 128) ? (a.n * 128 + tid) : ((a.n - 1) * 128 + tid - 128); const int t = sub >= 0 ? ((sub << a.dsh) + a.r) : 0;
        rc[0] = *(const f32x4*)(ropeA + t * 8); rc[1] = *(const f32x4*)(ropeA + t * 8 + 4); rc[2] = *(const f32x4*)(ropeA + SEQ * 8 + t * 8); rc[3] = *(const f32x4*)(ropeA + SEQ * 8 + t * 8 + 4); }
}
__device__ __forceinline__ void attn_stage(LAS unsigned char* lds, int tid, const u32x4 (&st)[10]) {
#pragma unroll
    for (int it = 0; it < 10; ++it) { const int idx = it * 512 + tid, row = idx >> 3, ch = idx & 7;
        const int sect = it < 2 ? 0 : (it < 6 ? 1 : 2); const int li = row - (sect == 0 ? 0 : (sect == 1 ? 128 : 384));
        *(LAS u32x4*)(lds + (sect == 0 ? AT_Q : (sect == 1 ? AT_K : AT_V)) + li * AT_P + ch * 16) = st[it]; }
}
__device__ __forceinline__ void attn_rotary(LAS unsigned char* lds, int tid, const f32x4 (&rc)[4]) {
    if (tid < 384) { LAS unsigned char* rp = lds + (tid < 128 ? AT_Q + tid * AT_P : AT_K + (tid - 128) * AT_P);
        const u32x4 a = *(LAS u32x4*)rp, b = *(LAS u32x4*)(rp + 16);
        float x1[8] = {bflo(a.x), bfhi(a.x), bflo(a.y), bfhi(a.y), bflo(a.z), bfhi(a.z), bflo(a.w), bfhi(a.w)};
        float x2[8] = {bflo(b.x), bfhi(b.x), bflo(b.y), bfhi(b.y), bflo(b.z), bfhi(b.z), bflo(b.w), bfhi(b.w)};
        float cs[8] = {rc[0][0], rc[0][1], rc[0][2], rc[0][3], rc[1][0], rc[1][1], rc[1][2], rc[1][3]}, sn[8] = {rc[2][0], rc[2][1], rc[2][2], rc[2][3], rc[3][0], rc[3][1], rc[3][2], rc[3][3]};
        float o1[8], o2[8];
#pragma unroll
        for (int j = 0; j < 8; ++j) { o1[j] = x1[j] * cs[j] - x2[j] * sn[j]; o2[j] = x1[j] * sn[j] + x2[j] * cs[j]; }
        u32x4 oa, ob; oa.x = cvtpk(o1[0], o1[1]); oa.y = cvtpk(o1[2], o1[3]); oa.z = cvtpk(o1[4], o1[5]); oa.w = cvtpk(o1[6], o1[7]);
        ob.x = cvtpk(o2[0], o2[1]); ob.y = cvtpk(o2[2], o2[3]); ob.z = cvtpk(o2[4], o2[5]); ob.w = cvtpk(o2[6], o2[7]);
        *(LAS u32x4*)rp = oa; *(LAS u32x4*)(rp + 16) = ob; }
}
__device__ __forceinline__ void attn_compute(LAS unsigned char* lds, int lane, int w, int u, bf16* P, float* LSE, bool do_store) {
    const AttnU au = attn_decode(u); const int n = au.n, dsh = au.dsh, r = au.r, g = au.g, h = au.h;
    const size_t rowb = (size_t)au.bl * SEQ;
    const int fr = lane & 15, fq = lane >> 4;
    bf16x8 qf[2];
#pragma unroll
    for (int ks = 0; ks < 2; ++ks) qf[ks] = *(LAS bf16x8*)(lds + AT_Q + (16 * w + fr) * AT_P + (32 * ks + 8 * fq) * 2);
    f32x4 sc[10];
#pragma unroll
    for (int tt = 0; tt < 10; ++tt) { const int t = (w + tt) < 15 ? (w + tt) : 15; f32x4 a = (f32x4){0.f, 0.f, 0.f, 0.f};
#pragma unroll
        for (int ks = 0; ks < 2; ++ks) { const bf16x8 kf = *(LAS bf16x8*)(lds + AT_K + (16 * t + fr) * AT_P + (32 * ks + 8 * fq) * 2); a = MFMA16(kf, qf[ks], a); }
        sc[tt] = a; if (tt & 1) __builtin_amdgcn_sched_barrier(0); }
    float mx = -3.0e38f;
#pragma unroll
    for (int tt = 0; tt < 10; ++tt)
#pragma unroll
        for (int i = 0; i < 4; ++i) { const int kr = 16 * tt + 4 * fq + i; const bool valid = (kr >= fr) && (kr <= fr + 128) && (n > 0 || (16 * w + kr >= 128));
            const float s = valid ? sc[tt][i] : -3.0e38f; sc[tt][i] = s; mx = fmaxf(mx, s); }
    mx = fmaxf(mx, __shfl_xor(mx, 16)); mx = fmaxf(mx, __shfl_xor(mx, 32));
    const float cexp = 0.125f * 1.4426950408889634f; float den = 0.f;
#pragma unroll
    for (int tt = 0; tt < 10; ++tt)
#pragma unroll
        for (int i = 0; i < 4; ++i) { const float p = __builtin_amdgcn_exp2f((sc[tt][i] - mx) * cexp); sc[tt][i] = p; den += p; }
    den += __shfl_xor(den, 16); den += __shfl_xor(den, 32);
    f32x4 o[4];
#pragma unroll
    for (int dt = 0; dt < 4; ++dt) o[dt] = (f32x4){0.f, 0.f, 0.f, 0.f};
    const int tq = fr >> 2, tp = fr & 3;
#pragma unroll
    for (int s = 0; s < 5; ++s) { const int t0 = (w + 2 * s) < 15 ? (w + 2 * s) : 15, t1 = (w + 2 * s + 1) < 15 ? (w + 2 * s + 1) : 15;
        u32x4 pw; pw.x = cvtpk(sc[2 * s][0], sc[2 * s][1]); pw.y = cvtpk(sc[2 * s][2], sc[2 * s][3]); pw.z = cvtpk(sc[2 * s + 1][0], sc[2 * s + 1][1]); pw.w = cvtpk(sc[2 * s + 1][2], sc[2 * s + 1][3]);
        const bf16x8 pf = __builtin_bit_cast(bf16x8, pw);
#pragma unroll
        for (int dt = 0; dt < 4; ++dt) { const s16x4 lo = trr(lds + AT_V + (16 * t0 + 4 * fq + tq) * AT_P + (16 * dt + 4 * tp) * 2), hi = trr(lds + AT_V + (16 * t1 + 4 * fq + tq) * AT_P + (16 * dt + 4 * tp) * 2);
            o[dt] = MFMA16(cat8(lo, hi), pf, o[dt]); } __builtin_amdgcn_sched_barrier(0); }
    if (!do_store) return;
    const float inv = 1.0f / den; const int tquery = ((n * 128 + 16 * w + fr) << dsh) + r; const size_t grow = rowb + tquery;
#pragma unroll
    for (int dt = 0; dt < 4; ++dt) { u32x2 wv; wv.x = cvtpk(o[dt][0] * inv, o[dt][1] * inv); wv.y = cvtpk(o[dt][2] * inv, o[dt][3] * inv);
        *(u32x2*)(P + PL_A + ((size_t)((au.bl * 3) * 24 + g * 8 + h) * 4096 + (r << (12 - dsh)) + n * 128 + 16 * w + fr) * 64 + 16 * dt + 4 * fq) = wv; }
    if (fq == 0) LSE[grow * 24 + g * 8 + h] = mx * 0.125f + __builtin_amdgcn_logf(den) * 0.6931471805599453f;
}

__device__ __forceinline__ void combine_rows(const Frame& F, int r0, int r1, const bf16* P, const float* LSE, bf16* COMB) {
    const int lane = F.lane, h = lane >> 3;
    for (int row = r0 + F.wave; row < r1; row += NWAVES) {
        const float l0 = LSE[(size_t)row * 24 + h], l1 = LSE[(size_t)row * 24 + 8 + h], l2 = LSE[(size_t)row * 24 + 16 + h];
        const float mx = fmaxf(l0, fmaxf(l1, l2));
        float e0 = __builtin_amdgcn_exp2f((l0 - mx) * 1.4426950408889634f), e1 = __builtin_amdgcn_exp2f((l1 - mx) * 1.4426950408889634f), e2 = __builtin_amdgcn_exp2f((l2 - mx) * 1.4426950408889634f);
        const float inv = 1.0f / (e0 + e1 + e2); e0 *= inv; e1 *= inv; e2 *= inv;
        const int bl = row >> 12, t = row & 4095, ch = lane & 7;
        const bf16* hb = P + PL_A + ((size_t)(bl * 3 * 24 + h) * 4096) * 64 + ch * 8;
        const u32x4 a = *(const u32x4*)(hb + (size_t)t * 64), b = *(const u32x4*)(hb + ((size_t)8 * 4096 + ((t & 3) << 10) + (t >> 2)) * 64), c = *(const u32x4*)(hb + ((size_t)16 * 4096 + ((t & 15) << 8) + (t >> 4)) * 64);
        u32x4 o;
        o.x = cvtpk(e0 * bflo(a.x) + e1 * bflo(b.x) + e2 * bflo(c.x), e0 * bfhi(a.x) + e1 * bfhi(b.x) + e2 * bfhi(c.x));
        o.y = cvtpk(e0 * bflo(a.y) + e1 * bflo(b.y) + e2 * bflo(c.y), e0 * bfhi(a.y) + e1 * bfhi(b.y) + e2 * bfhi(c.y));
        o.z = cvtpk(e0 * bflo(a.z) + e1 * bflo(b.z) + e2 * bflo(c.z), e0 * bfhi(a.z) + e1 * bfhi(b.z) + e2 * bfhi(c.z));
        o.w = cvtpk(e0 * bflo(a.w) + e1 * bflo(b.w) + e2 * bflo(c.w), e0 * bfhi(a.w) + e1 * bfhi(b.w) + e2 * bfhi(c.w));
        *(u32x4*)(COMB + (size_t)row * 512 + lane * 8) = o;
    }
}

constexpr int RT_QP = 272, RT_VP = 528;
constexpr int RT_Q = 0, RT_K = 128 * RT_QP, RT_V = 2 * 128 * RT_QP, RT_RED = RT_V + 128 * RT_VP;
__device__ __forceinline__ int crow(int i, int hh) { return (i & 3) + 8 * (i >> 2) + 4 * hh; }
__device__ __forceinline__ bf16x8 trfrag(LAS unsigned char* base, int pitch, int row0, int col0, int tq, int tp) {
    const s16x4 lo = trr(base + (row0 + tq) * pitch + (col0 + 4 * tp) * 2), hi = trr(base + (row0 + 4 + tq) * pitch + (col0 + 4 * tp) * 2);
    return cat8(lo, hi);
}
constexpr int NSEG = 16, NCS = 32 / NSEG;
__device__ __forceinline__ void ret_pass1(const Frame& F, int bl, int h, int seg, const bf16* P, float* Lbuf, const float* ropeR) {
    LAS unsigned char* lds = F.lds; const int w = F.wave;
    const float l2g = (h == 0) ? -0.04580368961312479f : (h == 1) ? -0.02272007650008353f : (h == 2) ? -0.011315313227834146f : -0.005646563141142062f;
    const float adec = __builtin_amdgcn_exp2f(128.0f * l2g);
    const size_t rowb = (size_t)bl * SEQ; const size_t hrow0 = (size_t)(bl * 4 + h) * 4096;
    f32x16 Sacc[4];
#pragma unroll
    for (int kt = 0; kt < 4; ++kt)
#pragma unroll
        for (int i = 0; i < 16; ++i) Sacc[kt][i] = 0.f;
    for (int c = seg * NCS; c < seg * NCS + NCS; ++c) {
        int tid = F.tid; asm volatile("" : "+v"(tid));
        const int lane = tid & 63, hh = lane >> 5, blk = (lane >> 4) & 1, tq = (lane & 15) >> 2, tp = lane & 3;
        const size_t crow0 = rowb + (size_t)c * 128;
#pragma unroll
        for (int it = 0; it < 2; ++it) { const int id = it * 512 + tid, row = id >> 3, ch = id & 7;
            const bf16* src = P + PL_QR + PL_QK_SZ + (hrow0 + (size_t)c * 128 + row) * 128 + ch * 8;
            const u32x4 a = *(const u32x4*)src, b = *(const u32x4*)(src + 64);
            const int pos = c * 128 + row; const unsigned* tp = (const unsigned*)ropeR + pos * 64 + ch * 8;
            const u32x4 t0v = *(const u32x4*)tp, t1v = *(const u32x4*)(tp + 4);
            float x1[8] = {bflo(a.x), bfhi(a.x), bflo(a.y), bfhi(a.y), bflo(a.z), bfhi(a.z), bflo(a.w), bfhi(a.w)};
            float x2[8] = {bflo(b.x), bfhi(b.x), bflo(b.y), bfhi(b.y), bflo(b.z), bfhi(b.z), bflo(b.w), bfhi(b.w)};
            float cs[8] = {bflo(t0v.x), bflo(t0v.y), bflo(t0v.z), bflo(t0v.w), bflo(t1v.x), bflo(t1v.y), bflo(t1v.z), bflo(t1v.w)}, sn[8] = {bfhi(t0v.x), bfhi(t0v.y), bfhi(t0v.z), bfhi(t0v.w), bfhi(t1v.x), bfhi(t1v.y), bfhi(t1v.z), bfhi(t1v.w)};
            const float sc = 0.08838834764831845f * __builtin_amdgcn_exp2f(l2g * (float)(127 - row)); float o1[8], o2[8];
#pragma unroll
            for (int j = 0; j < 8; ++j) { o1[j] = (x1[j] * cs[j] - x2[j] * sn[j]) * sc; o2[j] = (x1[j] * sn[j] + x2[j] * cs[j]) * sc; }
            u32x4 oa, ob; oa.x = cvtpk(o1[0], o1[1]); oa.y = cvtpk(o1[2], o1[3]); oa.z = cvtpk(o1[4], o1[5]); oa.w = cvtpk(o1[6], o1[7]);
            ob.x = cvtpk(o2[0], o2[1]); ob.y = cvtpk(o2[2], o2[3]); ob.z = cvtpk(o2[4], o2[5]); ob.w = cvtpk(o2[6], o2[7]);
            LAS unsigned char* dp = lds + RT_K + row * RT_QP + ch * 16;
            *(LAS u32x4*)dp = oa; *(LAS u32x4*)(dp + 128) = ob; }
#pragma unroll
        for (int it = 0; it < 8; ++it) { const int idx = it * 512 + tid, row = idx >> 5, ch = idx & 31;
            const u32x4 v = *(const u32x4*)(P + PL_VR + (hrow0 + (size_t)c * 128 + row) * 256 + ch * 8);
            *(LAS u32x4*)(lds + RT_V + row * RT_VP + ch * 16) = v; }
        __syncthreads();
#pragma unroll
        for (int kt = 0; kt < 4; ++kt)
#pragma unroll
            for (int i = 0; i < 16; ++i) Sacc[kt][i] *= adec;
#pragma unroll
        for (int ks = 0; ks < 8; ++ks) { const bf16x8 vf = trfrag(lds + RT_V, RT_VP, 16 * ks + 8 * hh, 32 * w + 16 * blk, tq, tp);
#pragma unroll
            for (int kt = 0; kt < 4; ++kt) { const bf16x8 kf = trfrag(lds + RT_K, RT_QP, 16 * ks + 8 * hh, 32 * kt + 16 * blk, tq, tp); Sacc[kt] = MFMA32(kf, vf, Sacc[kt]); } }
        __syncthreads();
    }
    unsigned* Lp = (unsigned*)Lbuf + ((size_t)((bl * 4 + h) * NSEG + seg) * 8 + w) * 2048 + F.lane;
#pragma unroll
    for (int kt = 0; kt < 4; ++kt)
#pragma unroll
        for (int i = 0; i < 8; ++i) Lp[(kt * 8 + i) * 64] = cvtpk(Sacc[kt][2 * i], Sacc[kt][2 * i + 1]);
}
__device__ __forceinline__ void ret_unit(const Frame& F, int bl, int h, int seg, const bf16* P, bf16* RET, const float* Lbuf, const float* ropeR) {
    const int c0 = seg * NCS, c1 = c0 + NCS;
    LAS unsigned char* lds = F.lds; const int w = F.wave;
    const float l2g = (h == 0) ? -0.04580368961312479f : (h == 1) ? -0.02272007650008353f : (h == 2) ? -0.011315313227834146f : -0.005646563141142062f;
    const float adec = __builtin_amdgcn_exp2f(128.0f * l2g);
    const size_t rowb = (size_t)bl * SEQ; const size_t hrow0 = (size_t)(bl * 4 + h) * 4096;
    f32x16 Sacc[4], out[4];
#pragma unroll
    for (int kt = 0; kt < 4; ++kt)
#pragma unroll
        for (int i = 0; i < 16; ++i) Sacc[kt][i] = 0.f;
    { const float aseg = __builtin_amdgcn_exp2f(128.0f * (float)NCS * l2g);
      const unsigned* Lb = (const unsigned*)Lbuf + ((size_t)((bl * 4 + h) * NSEG) * 8 + w) * 2048 + F.lane; int sp = 0;
      for (; sp + 2 < seg; sp += 3) { const unsigned* L0 = Lb + (size_t)sp * 8 * 2048; unsigned t[3][32];
#pragma unroll
        for (int q = 0; q < 3; ++q)
#pragma unroll
            for (int j = 0; j < 32; ++j) t[q][j] = L0[(size_t)q * 8 * 2048 + j * 64];
#pragma unroll
        for (int q = 0; q < 3; ++q)
#pragma unroll
            for (int kt = 0; kt < 4; ++kt)
#pragma unroll
                for (int i = 0; i < 8; ++i) { Sacc[kt][2 * i] = Sacc[kt][2 * i] * aseg + bflo(t[q][kt * 8 + i]); Sacc[kt][2 * i + 1] = Sacc[kt][2 * i + 1] * aseg + bfhi(t[q][kt * 8 + i]); } }
      for (; sp < seg; ++sp) { const unsigned* L0 = Lb + (size_t)sp * 8 * 2048; unsigned t[32];
#pragma unroll
        for (int j = 0; j < 32; ++j) t[j] = L0[j * 64];
#pragma unroll
        for (int kt = 0; kt < 4; ++kt)
#pragma unroll
            for (int i = 0; i < 8; ++i) { Sacc[kt][2 * i] = Sacc[kt][2 * i] * aseg + bflo(t[kt * 8 + i]); Sacc[kt][2 * i + 1] = Sacc[kt][2 * i + 1] * aseg + bfhi(t[kt * 8 + i]); } } }
    for (int c = c0; c < c1; ++c) {
        int tid = F.tid; asm volatile("" : "+v"(tid));
        const int lane = tid & 63, r = lane & 31, hh = lane >> 5, blk = (lane >> 4) & 1, tq = (lane & 15) >> 2, tp = lane & 3;
        const size_t crow0 = rowb + (size_t)c * 128;
#pragma unroll
        for (int it = 0; it < 4; ++it) { const int id = (it & 1) * 512 + tid, row = id >> 3, ch = id & 7; const bool isk = it >= 2;
            const bf16* src = P + PL_QR + (isk ? PL_QK_SZ : (size_t)0) + (hrow0 + (size_t)c * 128 + row) * 128 + ch * 8;
            const u32x4 a = *(const u32x4*)src, b = *(const u32x4*)(src + 64);
            const int pos = c * 128 + row; const unsigned* tp = (const unsigned*)ropeR + pos * 64 + ch * 8;
            const u32x4 t0v = *(const u32x4*)tp, t1v = *(const u32x4*)(tp + 4);
            float x1[8] = {bflo(a.x), bfhi(a.x), bflo(a.y), bfhi(a.y), bflo(a.z), bfhi(a.z), bflo(a.w), bfhi(a.w)};
            float x2[8] = {bflo(b.x), bfhi(b.x), bflo(b.y), bfhi(b.y), bflo(b.z), bfhi(b.z), bflo(b.w), bfhi(b.w)};
            float cs[8] = {bflo(t0v.x), bflo(t0v.y), bflo(t0v.z), bflo(t0v.w), bflo(t1v.x), bflo(t1v.y), bflo(t1v.z), bflo(t1v.w)}, sn[8] = {bfhi(t0v.x), bfhi(t0v.y), bfhi(t0v.z), bfhi(t0v.w), bfhi(t1v.x), bfhi(t1v.y), bfhi(t1v.z), bfhi(t1v.w)};
            const float sc = isk ? 0.08838834764831845f : 1.0f; float o1[8], o2[8];
#pragma unroll
            for (int j = 0; j < 8; ++j) { o1[j] = (x1[j] * cs[j] - x2[j] * sn[j]) * sc; o2[j] = (x1[j] * sn[j] + x2[j] * cs[j]) * sc; }
            u32x4 oa, ob; oa.x = cvtpk(o1[0], o1[1]); oa.y = cvtpk(o1[2], o1[3]); oa.z = cvtpk(o1[4], o1[5]); oa.w = cvtpk(o1[6], o1[7]);
            ob.x = cvtpk(o2[0], o2[1]); ob.y = cvtpk(o2[2], o2[3]); ob.z = cvtpk(o2[4], o2[5]); ob.w = cvtpk(o2[6], o2[7]);
            LAS unsigned char* dp = lds + (isk ? RT_K : RT_Q) + row * RT_QP + ch * 16;
            *(LAS u32x4*)dp = oa; *(LAS u32x4*)(dp + 128) = ob; }
#pragma unroll
        for (int it = 0; it < 8; ++it) { const int idx = it * 512 + tid, row = idx >> 5, ch = idx & 31;
            const u32x4 v = *(const u32x4*)(P + PL_VR + (hrow0 + (size_t)c * 128 + row) * 256 + ch * 8);
            *(LAS u32x4*)(lds + RT_V + row * RT_VP + ch * 16) = v; }
        __syncthreads();
        u32x2 gpre[4][4];
#pragma unroll
        for (int pt = 0; pt < 4; ++pt)
#pragma unroll
            for (int gi = 0; gi < 4; ++gi) gpre[pt][gi] = *(const u32x2*)(P + PL_VR + PL_VG_SZ + (hrow0 + (size_t)c * 128 + 32 * pt + r) * 256 + 32 * w + 8 * gi + 4 * hh);
        const int ci = w >> 1, mi0 = 2 * (w & 1);
        unsigned smp[2][8];
#pragma unroll
        for (int t2 = 0; t2 < 2; ++t2) { const int mi = mi0 + t2; f32x16 x;
#pragma unroll
            for (int i = 0; i < 16; ++i) x[i] = 0.f;
            if (mi <= ci) {
#pragma unroll
                for (int ks = 0; ks < 8; ++ks) { const bf16x8 a = *(LAS bf16x8*)(lds + RT_Q + (32 * ci + r) * RT_QP + (16 * ks + 8 * hh) * 2), b = *(LAS bf16x8*)(lds + RT_K + (32 * mi + r) * RT_QP + (16 * ks + 8 * hh) * 2);
                    x = MFMA32(a, b, x); } }
#pragma unroll
            for (int i = 0; i < 16; ++i) { const int dlt = (32 * ci + crow(i, hh)) - (32 * mi + r); x[i] = dlt >= 0 ? x[i] * __builtin_amdgcn_exp2f(l2g * (float)dlt) : 0.f; }
#pragma unroll
            for (int i = 0; i < 8; ++i) smp[t2][i] = cvtpk(x[2 * i], x[2 * i + 1]); }
#pragma unroll
        for (int pt = 0; pt < 4; ++pt)
#pragma unroll
            for (int i = 0; i < 16; ++i) out[pt][i] = 0.f;
#pragma unroll
        for (int kt = 0; kt < 4; ++kt)
#pragma unroll
            for (int s = 0; s < 2; ++s) { u32x4 pw; pw.x = cvtpk(Sacc[kt][8 * s], Sacc[kt][8 * s + 1]); pw.y = cvtpk(Sacc[kt][8 * s + 2], Sacc[kt][8 * s + 3]); pw.z = cvtpk(Sacc[kt][8 * s + 4], Sacc[kt][8 * s + 5]); pw.w = cvtpk(Sacc[kt][8 * s + 6], Sacc[kt][8 * s + 7]);
                const bf16x8 sf = __builtin_bit_cast(bf16x8, pw);
#pragma unroll
                for (int pt = 0; pt < 4; ++pt) { LAS unsigned char* qp = lds + RT_Q + (32 * pt + r) * RT_QP + (32 * kt + 16 * s + 4 * hh) * 2;
                    const s16x4 lo = *(LAS s16x4*)qp, hi = *(LAS s16x4*)(qp + 16);
                    out[pt] = MFMA32(sf, cat8(lo, hi), out[pt]); } __builtin_amdgcn_sched_barrier(0); }
#pragma unroll
        for (int pt = 0; pt < 4; ++pt) { const float xi = __builtin_amdgcn_exp2f(l2g * (float)(32 * pt + r + 1));
#pragma unroll
            for (int i = 0; i < 16; ++i) out[pt][i] *= xi; }
        __syncthreads();
#pragma unroll
        for (int t2 = 0; t2 < 2; ++t2) { const int mi = mi0 + t2;
            if (mi <= ci) {
#pragma unroll
                for (int i = 0; i < 16; ++i) { const unsigned wv = smp[t2][i >> 1]; const unsigned short hv = (i & 1) ? (unsigned short)(wv >> 16) : (unsigned short)(wv & 0xffffu);
                    *(LAS unsigned short*)(lds + RT_Q + (32 * ci + crow(i, hh)) * RT_QP + (32 * mi + r) * 2) = hv; } } }
#pragma unroll
        for (int it = 0; it < 4; ++it) { const int idx = it * 512 + tid, row = idx >> 4, ch = idx & 15; LAS u32x4* kp = (LAS u32x4*)(lds + RT_K + row * RT_QP + ch * 16);
            const u32x4 v = *kp; const float z = __builtin_amdgcn_exp2f(l2g * (float)(127 - row)); u32x4 o;
            o.x = cvtpk(bflo(v.x) * z, bfhi(v.x) * z); o.y = cvtpk(bflo(v.y) * z, bfhi(v.y) * z); o.z = cvtpk(bflo(v.z) * z, bfhi(v.z) * z); o.w = cvtpk(bflo(v.w) * z, bfhi(v.w) * z); *kp = o; }
        __syncthreads();
#pragma unroll
        for (int kt = 0; kt < 4; ++kt)
#pragma unroll
            for (int i = 0; i < 16; ++i) Sacc[kt][i] *= adec;
#pragma unroll
        for (int ks = 0; ks < 8; ++ks) { const bf16x8 vf = trfrag(lds + RT_V, RT_VP, 16 * ks + 8 * hh, 32 * w + 16 * blk, tq, tp);
#pragma unroll
            for (int pt = 0; pt < 4; ++pt) if (ks < 2 * (pt + 1)) { const bf16x8 smf = *(LAS bf16x8*)(lds + RT_Q + (32 * pt + r) * RT_QP + (16 * ks + 8 * hh) * 2); out[pt] = MFMA32(vf, smf, out[pt]); }
#pragma unroll
            for (int kt = 0; kt < 4; ++kt) { const bf16x8 kf = trfrag(lds + RT_K, RT_QP, 16 * ks + 8 * hh, 32 * kt + 16 * blk, tq, tp); Sacc[kt] = MFMA32(kf, vf, Sacc[kt]); } __builtin_amdgcn_sched_barrier(0); }
        LAS float* red = (LAS float*)(lds + RT_RED);
#pragma unroll
        for (int pt = 0; pt < 4; ++pt) { float ss = 0.f;
#pragma unroll
            for (int i = 0; i < 16; ++i) ss += out[pt][i] * out[pt][i];
            ss += __shfl_xor(ss, 32);
            if (hh == 0) red[(32 * pt + r) * 8 + w] = ss; }
        __syncthreads();
#pragma unroll
        for (int pt = 0; pt < 4; ++pt) { const LAS f32x4* rp = (const LAS f32x4*)(red + (32 * pt + r) * 8); const f32x4 a = rp[0], b = rp[1];
            const float tot = ((a[0] + a[1]) + (a[2] + a[3])) + ((b[0] + b[1]) + (b[2] + b[3])); const float rs = 1.0f / sqrtf(tot * (1.0f / 256.0f) + 1e-6f);
            const size_t grow = crow0 + 32 * pt + r;
#pragma unroll
            for (int gi = 0; gi < 4; ++gi) { const int dv0 = 32 * w + 8 * gi + 4 * hh; const u32x2 gv = gpre[pt][gi];
                const float g0 = bflo(gv.x), g1 = bfhi(gv.x), g2 = bflo(gv.y), g3 = bfhi(gv.y);
                u32x2 o; o.x = cvtpk(out[pt][4 * gi] * rs * g0 * sigmoidf_(g0), out[pt][4 * gi + 1] * rs * g1 * sigmoidf_(g1)); o.y = cvtpk(out[pt][4 * gi + 2] * rs * g2 * sigmoidf_(g2), out[pt][4 * gi + 3] * rs * g3 * sigmoidf_(g3));
                *(u32x2*)(RET + grow * 1024 + h * 256 + dv0) = o; } __builtin_amdgcn_sched_barrier(0); }
    }
}

#define XB_TMO      128
#define XB_XCNT(j)  (256  + 64 * (j))
#define XB_XSUB(j)  (1280 + 64 * (j))
#define XB_XGEN(j)  (2304 + 64 * (j))
#define XB_TOP      3328
#define XB_TOPGEN   3392
#define XCD_BAR_WORDS 3456
#define XB_SPIN_CAP (1u << 18)

__device__ __forceinline__ unsigned xb_ld(unsigned* p)              { return __hip_atomic_load(p, __ATOMIC_RELAXED, __HIP_MEMORY_SCOPE_AGENT); }
__device__ __forceinline__ unsigned xb_add(unsigned* p, unsigned v) { return __hip_atomic_fetch_add(p, v, __ATOMIC_RELAXED, __HIP_MEMORY_SCOPE_AGENT); }
__device__ __forceinline__ unsigned xb_xcc_id() { return (unsigned)__builtin_amdgcn_s_getreg((3 << 11) | 20) & 0xFu; }
#define XB_SPIN(cond, bar) do { unsigned _sp = 0; while (cond) { __builtin_amdgcn_s_sleep(1); \
    if ((++_sp & 255u) == 0u) { if (xb_ld(&(bar)[XB_TMO])) break; if (_sp > XB_SPIN_CAP) { atomicAdd(&(bar)[XB_TMO], 1u); break; } } } } while (0)

struct XcdBarrier {
    unsigned* bar; unsigned x;
    volatile LAS unsigned* st;
};

__device__ __forceinline__ XcdBarrier xcd_barrier_post(unsigned* bar, volatile LAS unsigned* st) {
    XcdBarrier b; b.bar = bar; b.x = xb_xcc_id(); b.st = st;
    if (threadIdx.x == 0) (void)xb_add(&bar[XB_XCNT(b.x)], 1u);
    return b;
}
__device__ __forceinline__ void xcd_barrier_complete(unsigned* bar, unsigned x, unsigned& nloc, unsigned& nx) {
    const unsigned G = gridDim.x * gridDim.y * gridDim.z;
    unsigned sum, cnt, mine, sp = 0u;
    for (;;) {
        sum = 0u; cnt = 0u; mine = 0u;
#pragma unroll
        for (unsigned j = 0; j < 16; ++j) { const unsigned c = xb_ld(&bar[XB_XCNT(j)]); sum += c; cnt += (c > 0u) ? 1u : 0u; mine = (j == x) ? c : mine; }
        if (sum == G) break;
        __builtin_amdgcn_s_sleep(1);
        if ((++sp & 255u) == 0u) { if (xb_ld(&bar[XB_TMO])) break; if (sp > XB_SPIN_CAP) { atomicAdd(&bar[XB_TMO], 1u); break; } }
    }
    nloc = mine > 0u ? mine : 1u; nx = cnt > 0u ? cnt : 1u;
}

__device__ __forceinline__ void xcd_barrier(const XcdBarrier& b) {
    asm volatile("s_waitcnt vmcnt(0)" ::: "memory");
    __syncthreads();
    if (threadIdx.x == 0) {
        unsigned* bar = b.bar;
        __builtin_amdgcn_s_waitcnt(0);
        unsigned nloc = b.st[0], nx = b.st[1];
        if (nloc == 0u) { xcd_barrier_complete(bar, b.x, nloc, nx); b.st[0] = nloc; b.st[1] = nx; }
        const unsigned old = xb_add(&bar[XB_XSUB(b.x)], 1u);
        const unsigned gen = old / nloc;
        if (old + 1u == (gen + 1u) * nloc) {
            __builtin_amdgcn_fence(__ATOMIC_RELEASE, "agent");
            asm volatile("s_waitcnt vmcnt(0)" ::: "memory");
            const unsigned og = xb_add(&bar[XB_TOP], 1u);
            const unsigned tg = og / nx;
            if (og + 1u == (tg + 1u) * nx) xb_add(&bar[XB_TOPGEN], 1u);
            else XB_SPIN(xb_ld(&bar[XB_TOPGEN]) == tg, bar);
            __builtin_amdgcn_fence(__ATOMIC_ACQUIRE, "agent");
            xb_add(&bar[XB_XGEN(b.x)], 1u);
            asm volatile("s_waitcnt vmcnt(0)" ::: "memory");
        } else {
            XB_SPIN(xb_ld(&bar[XB_XGEN(b.x)]) == gen, bar);
            __builtin_amdgcn_fence(__ATOMIC_ACQUIRE, "agent");
            asm volatile("s_waitcnt vmcnt(0)" ::: "memory");
        }
    }
    __syncthreads();
}

#ifndef DIS_P0
#define DIS_P0 0
#endif
#ifndef DIS_G1
#define DIS_G1 0
#endif
#ifndef DIS_MIX
#define DIS_MIX 0
#endif
#ifndef DIS_RET
#define DIS_RET 0
#endif
#ifndef DIS_ATT
#define DIS_ATT 0
#endif
#ifndef DIS_CMB
#define DIS_CMB 0
#endif
#ifndef DIS_GY
#define DIS_GY 0
#endif
#ifndef DIS_GO
#define DIS_GO 0
#endif
#ifndef DIS_UP
#define DIS_UP 0
#endif
#ifndef DIS_DN
#define DIS_DN 0
#endif
#ifndef DIS_FIN
#define DIS_FIN 0
#endif
#ifndef REP_P0
#define REP_P0 1
#endif
#ifndef REP_G1
#define REP_G1 1
#endif
#ifndef REP_P2
#define REP_P2 1
#endif
#ifndef REP_P3
#define REP_P3 1
#endif
#ifndef REP_GY
#define REP_GY 1
#endif
#ifndef REP_UP
#define REP_UP 1
#endif
struct Args { const float* in[10]; float* out; unsigned char* ws; int ph_lo, ph_hi; };

__global__ void __launch_bounds__(NTHR, 2) fwd_kernel(Args args) {
    extern __shared__ __attribute__((aligned(16))) unsigned char lds_raw[];
    cg::grid_group grid = cg::this_grid();
    Frame F; F.lds = (LAS unsigned char*)lds_raw; F.tid = threadIdx.x; F.lane = F.tid & 63; F.wave = __builtin_amdgcn_readfirstlane(F.tid >> 6); F.G = gridDim.x;
    Ptrs A; A.x = args.in[0]; A.mix_norm = args.in[1]; A.w_in = args.in[2]; A.w_a = args.in[3]; A.w_b = args.in[4]; A.w_o = args.in[5]; A.ffn_norm = args.in[6]; A.w_up = args.in[7]; A.w_down = args.in[8]; A.final_norm = args.in[9];
    A.out = args.out; A.ws = args.ws;
    unsigned char* ws = args.ws;
    unsigned* ctl = (unsigned*)(ws + WS_CTL);
    bf16* XN = (bf16*)(ws + WS_XN); bf16* Pb = (bf16*)(ws + WS_P); bf16* Gb = (bf16*)(ws + WS_G); bf16* COMB = (bf16*)(ws + WS_COMB); bf16* RET = (bf16*)(ws + WS_RET);
    bf16* SCR = (bf16*)(ws + WS_SCR); bf16* MRG = (bf16*)(ws + WS_MRG); bf16* Hb = (bf16*)(ws + WS_H);
    float* PART = (float*)(ws + WS_PART); float* LSE = (float*)(ws + WS_LSE);
    const float* ropeA = (const float*)(ws + WS_ROPEA); const float* ropeR = (const float*)(ws + WS_ROPER);
    if (F.tid < 8) ((LAS unsigned*)(F.lds + LDS_BYTES - 32))[F.tid] = 0u;
    __syncthreads();
    XcdBarrier bar = xcd_barrier_post((unsigned*)(ws + WS_BAR), (volatile LAS unsigned*)(F.lds + LDS_BYTES - 32));
    const int lo = args.ph_lo, hi = args.ph_hi; int ph = 0;
#define PH_ON (ph >= lo && ph < hi)
#define RELAUNDER do { int t_ = threadIdx.x; asm volatile("" : "+v"(t_)); F.tid = t_; F.lane = t_ & 63; bx = blockIdx.x; asm volatile("" : "+s"(bx)); } while (0)
    int bx = blockIdx.x;
#define PH_END do { if (ph >= lo && ph + 1 < hi) { if (lo < 0) grid.sync(); else xcd_barrier(bar); } ++ph; } while (0)

    if (PH_ON && !DIS_P0) for (int rep = 0; rep < REP_P0; ++rep) p0_prologue(F, A);
    PH_END;
    for (int l = 0; l < 2; ++l) {
        unsigned char* wl = ws + WS_W + (size_t)l * W_LAYER;
        for (int rd = 0; rd < 2; ++rd) {
            const size_t roff = (size_t)rd * MG;
            if (PH_ON && !DIS_G1) {
                RELAUNDER;
                pg8::Gemm g{XN + roff * DM, (const bf16*)(wl + W_IN), MG, DIN, DM}; pg8::StaticOrder S; S.init(MG, DIN, F.G, bx);
                LAS float* rsl = (LAS float*)(F.lds + 131072);
                { pg8::Unit u0; S.next(0, u0);
                  if (F.tid < 256) rsl[F.tid] = pg8::row_rstd(PART + roff * 16, u0.pm * 256 + F.tid);
                  __syncthreads(); }
                pg8::EpiProj E{Pb, Gb, rsl};
                for (int rep = 0; rep < REP_G1; ++rep) { pg8::gemm_phase<pg8::EpiProj, pg8::StaticOrder, true, true>(F.lds, g, S, E); __syncthreads(); }
            }
            PH_END;
            if (PH_ON && !DIS_MIX) {
                RELAUNDER;
                unsigned* ctr = ctl + 16 * (l * 2 + rd);
                float* Lbuf = A.out;
                constexpr int NR1 = 16 * (NSEG - 1);
                for (int rep = 0; rep < REP_P2; ++rep) {
                    const int UEND = NR1 + 3072; volatile LAS unsigned* bc = (volatile LAS unsigned*)(F.lds + LDS_BCAST);
                    int u = queue_next(ctr + rep, F.lds, F.tid);
                    while (u < NR1) { ret_pass1(F, (u & 15) >> 2, u & 3, u >> 4, Pb, Lbuf, ropeR); u = queue_next(ctr + rep, F.lds, F.tid); }
                    u = NR1 + 2 * (u - NR1);
                    u32x4 st[10]; f32x4 rc[4];
#pragma unroll
                    for (int i = 0; i < 10; ++i) st[i] = (u32x4){0u, 0u, 0u, 0u};
#pragma unroll
                    for (int i = 0; i < 4; ++i) rc[i] = (f32x4){0.f, 0.f, 0.f, 0.f};
                    if (u < UEND) attn_load(F.tid, u - NR1, Pb, ropeA, st, rc);
                    while (u < UEND) {
                        int tl = F.tid; asm volatile("" : "+v"(tl));
                        const bool first = ((u - NR1) & 1) == 0;
                        if (tl == 0 && !first) *bc = NR1 + 2 * (atomicAdd(ctr + rep, 1u) - NR1);
                        attn_stage(F.lds, tl, st);
                        __syncthreads();
                        const int un = first ? u + 1 : (int)*bc;
                        attn_rotary(F.lds, tl, rc);
                        if (un < UEND) attn_load(tl, un - NR1, Pb, ropeA, st, rc);
                        __syncthreads();
                        attn_compute(F.lds, tl & 63, F.wave, u - NR1, Pb, LSE, rep == REP_P2 - 1);
                        __syncthreads();
                        u = un;
                    }
                }
            }
            PH_END;
            if (PH_ON && !DIS_CMB) { RELAUNDER;
                unsigned* ctr = ctl + 16 * (4 + l * 2 + rd); const float* Lbuf = A.out;
                for (int rep = 0; rep < REP_P3; ++rep) {
                if (F.G == 16 * NSEG) ret_unit(F, (bx & 15) >> 2, bx & 3, NSEG - 1 - (bx >> 4), Pb, RET, Lbuf, ropeR);
                else for (;;) { const int u = queue_next(ctr + 8 + rep, F.lds, F.tid); if (u >= 16 * NSEG) break; ret_unit(F, (u & 15) >> 2, u & 3, NSEG - 1 - (u >> 4), Pb, RET, Lbuf, ropeR); }
                for (;;) { const int cu = queue_next(ctr + rep, F.lds, F.tid); if (cu >= MG / 64) break; combine_rows(F, cu * 64, cu * 64 + 64, Pb, LSE, COMB); } } }
            PH_END;
            if (PH_ON && !DIS_GY) {
                RELAUNDER;
                for (int rep = 0; rep < REP_GY; ++rep) {
                { pg8::Gemm g{COMB, (const bf16*)(wl + W_A), MG, DM, 512}; pg8::StaticOrder S; S.init(MG, DM, F.G, bx); pg8::EpiGateA E{Gb, SCR};
                  pg8::gemm_phase<pg8::EpiGateA, pg8::StaticOrder, true, true>(F.lds, g, S, E); }
                __syncthreads();
                { pg8::Gemm g{RET, (const bf16*)(wl + W_B), MG, DM, DM}; pg8::StaticOrder S; S.init(MG, DM, F.G, bx); pg8::EpiGateB E{Gb, SCR, MRG};
                  pg8::gemm_phase<pg8::EpiGateB, pg8::StaticOrder, true, true>(F.lds, g, S, E); }
                __syncthreads(); }
            }
            PH_END;
            if (PH_ON && !DIS_GO) {
                RELAUNDER;
                pg8::Gemm g{MRG, (const bf16*)(wl + W_O), MG, DM, DM}; pg8::StaticOrder S; S.init(MG, DM, F.G, bx);
                pg8::EpiResid E{XN + roff * DM, PART + roff * 16};
                pg8::gemm_phase<pg8::EpiResid, pg8::StaticOrder, true, true>(F.lds, g, S, E);
            }
            PH_END;
        }
        if (PH_ON && !DIS_UP) {
            RELAUNDER;
            pg8::Gemm g{XN, (const bf16*)(wl + W_UP), M, DFF, DM}; pg8::StaticOrder S; S.init(M, DFF, F.G, bx); LAS float* rsl = (LAS float*)(F.lds + 131072);
            pg8::Unit ua, ub; S.next(0, ua); S.next(4, ub);
            if (F.tid < 256) rsl[F.tid] = pg8::row_rstd(PART, ua.pm * 256 + F.tid); else rsl[F.tid] = pg8::row_rstd(PART, ub.pm * 256 + (F.tid - 256));
            __syncthreads();
            pg8::EpiUp E{Hb, rsl, ua.pm};
            for (int rep = 0; rep < REP_UP; ++rep) { pg8::gemm_phase<pg8::EpiUp, pg8::StaticOrder, true, true>(F.lds, g, S, E); __syncthreads(); }
        }
        PH_END;
        if (PH_ON && !DIS_DN) {
            RELAUNDER;
            pg8::Gemm g{Hb, (const bf16*)(wl + W_DN), M, DM, DFF}; pg8::StaticOrder S; S.init(M, DM, F.G, bx); pg8::EpiResid E{XN, PART};
            pg8::gemm_phase<pg8::EpiResid, pg8::StaticOrder, true, true>(F.lds, g, S, E);
        }
        PH_END;
    }
    if (PH_ON && !DIS_FIN) {
        const int gw = blockIdx.x * NWAVES + F.wave, NGW = F.G * NWAVES;
        for (int m = gw; m < M; m += NGW) { const float rs = pg8::row_rstd(PART, m); f32x4* xr = (f32x4*)(A.out + (size_t)m * DM) + F.lane; const f32x4* gr = (const f32x4*)A.final_norm + F.lane;
            const u32x2* xb = (const u32x2*)(XN + (size_t)m * DM) + F.lane;
#pragma unroll
            for (int j = 0; j < 4; ++j) { const u32x2 b = xb[64 * j]; const f32x4 v = (f32x4){bflo(b.x), bfhi(b.x), bflo(b.y), bfhi(b.y)}, gg = gr[64 * j]; xr[64 * j] = v * rs * gg; } }
    }
#undef PH_ON
#undef PH_END
}

#ifndef N_LAUNCH_MODE
#define N_LAUNCH_MODE 0
#endif
extern "C" void kernel_launch(void* const* d_in, const int* in_sizes, int n_in, void* d_out, int out_size, void* d_ws, size_t ws_size, hipStream_t stream) {
    static int grid = 0;
    if (grid == 0) {
        if (n_in != 10 || in_sizes[0] != M * DM || out_size != M * DM || ws_size < WS_END) { fprintf(stderr, "kernel_launch: unexpected shapes / workspace (n_in %d, in0 %d, out %d, ws %zu)\n", n_in, n_in > 0 ? in_sizes[0] : -1, out_size, ws_size); grid = -1; return; }
        int dev = 0, cus = 0, per_cu = 0;
        hipGetDevice(&dev); hipDeviceGetAttribute(&cus, hipDeviceAttributeMultiprocessorCount, dev);
        if (hipFuncSetAttribute((const void*)fwd_kernel, hipFuncAttributeMaxDynamicSharedMemorySize, LDS_BYTES) != hipSuccess) { fprintf(stderr, "kernel_launch: hipFuncSetAttribute failed\n"); grid = -1; return; }
        if (hipOccupancyMaxActiveBlocksPerMultiprocessor(&per_cu, (const void*)fwd_kernel, NTHR, LDS_BYTES) != hipSuccess || per_cu < 1) { fprintf(stderr, "kernel_launch: occupancy query gave %d\n", per_cu); per_cu = 1; }
        (void)hipGetLastError();
        grid = cus * 1;
        fprintf(stderr, "kernel_launch: cus %d per_cu %d grid %d ws %zu\n", cus, per_cu, grid, ws_size);
    }
    if (grid < 0) return;
    (void)hipMemsetAsync((char*)d_ws + WS_CTL, 0, CTL_BYTES, stream);
    Args a{};
    for (int i = 0; i < 10; ++i) a.in[i] = (const float*)d_in[i];
    a.out = (float*)d_out; a.ws = (unsigned char*)d_ws;
#if N_LAUNCH_MODE == 0
    a.ph_lo = 0; a.ph_hi = N_PHASES;
    void* kargs[] = {&a};
    hipError_t e = hipLaunchCooperativeKernel((const void*)fwd_kernel, dim3(grid), dim3(NTHR), kargs, LDS_BYTES, stream);
    if (e != hipSuccess) fprintf(stderr, "kernel_launch: cooperative launch failed: %s (grid %d)\n", hipGetErrorString(e), grid);
#else
    for (int p = 0; p < N_PHASES; ++p) { a.ph_lo = p; a.ph_hi = p + 1; hipLaunchKernelGGL(fwd_kernel, dim3(grid), dim3(NTHR), LDS_BYTES, stream, a); }
#endif
}
```
